# Optimizing an MI355X kernel written in HIP

```python
import math
import jax, jax.numpy as jnp
from jax import lax
import numpy as np

D_MODEL = 2048
BATCH = 2
SEQ = 8192
DEPTH = 1

HG_HEADS = 8
HG_DK = 128
HG_DV = 128
HG_KEY = HG_HEADS * HG_DK
HG_VAL = HG_HEADS * HG_DV
HG_CHUNK = 64
SSD_HEADS = 16
SSD_HEADDIM = 64
SSD_WIDTH = SSD_HEADS * SSD_HEADDIM
SSD_GROUPS = 2
SSD_HPG = SSD_HEADS // SSD_GROUPS
SSD_STATE = 128
SSD_CONV = 4
SSD_CHUNK = 128
SSD_CONV_DIM = SSD_WIDTH + 2 * SSD_GROUPS * SSD_STATE
D_MIX = HG_VAL + SSD_WIDTH
D_FF = ((8 * D_MODEL + 3 * 256 - 1) // (3 * 256)) * 256
NORM_EPS = 1e-6
IN_SPLITS = (HG_KEY, HG_KEY, HG_VAL, HG_VAL, SSD_WIDTH, SSD_CONV_DIM, SSD_HEADS)
N_IN = HG_KEY * 2 + HG_VAL * 2 + SSD_WIDTH + SSD_CONV_DIM + SSD_HEADS

kernel_name = "hgrn2_mamba2_parallel_hybrid_block"


def _split_points():
    pts, acc = [], 0
    for s in IN_SPLITS[:-1]:
        acc += s
        pts.append(acc)
    return pts


def rms_norm(x, w):
    xf = x.astype(jnp.float32)
    y = xf * lax.rsqrt(jnp.mean(xf * xf, axis=-1, keepdims=True) + NORM_EPS)
    return (y * w.astype(jnp.float32)).astype(x.dtype)


def group_rms_norm(x, w, n_groups):
    xf = x.astype(jnp.float32)
    shp = xf.shape
    xg = xf.reshape(shp[:-1] + (n_groups, shp[-1] // n_groups))
    xg = xg * lax.rsqrt(jnp.mean(xg * xg, axis=-1, keepdims=True) + NORM_EPS)
    return xg.reshape(shp) * w.astype(jnp.float32)


def hgrn2_mixer(q_raw, f_raw, i_in, g_in, lb, norm_w):
    bsz, seqlen, _ = q_raw.shape
    nc = seqlen // HG_CHUNK
    q = jax.nn.silu(q_raw.astype(jnp.float32)) * (HG_DK ** -0.5)
    forget = lb + (1.0 - lb) * jax.nn.sigmoid(f_raw.astype(jnp.float32))
    log_f = jnp.log(forget)
    k = 1.0 - forget
    v = i_in.astype(jnp.float32)

    def to_chunks(t, d):
        return t.reshape(bsz, nc, HG_CHUNK, HG_HEADS, d).transpose(1, 0, 3, 2, 4)

    causal = jnp.tril(jnp.ones((HG_CHUNK, HG_CHUNK), dtype=bool))

    def step(S, inp):
        qc, kc, vc, gc = inp
        b = jnp.cumsum(gc, axis=2)
        rel = jnp.where(causal[:, :, None], b[:, :, :, None, :] - b[:, :, None, :, :], -jnp.inf)
        scores = jnp.sum(qc[:, :, :, None, :] * kc[:, :, None, :, :] * jnp.exp(rel), axis=-1)
        o = (jnp.einsum('bhts,bhsv->bhtv', scores, vc)
             + jnp.einsum('bhtk,bhkv->bhtv', qc * jnp.exp(b), S))
        b_last = b[:, :, -1, :]
        S_new = (S * jnp.exp(b_last)[..., None]
                 + jnp.einsum('bhsk,bhsv->bhkv', kc * jnp.exp(b_last[:, :, None, :] - b), vc))
        return S_new, o

    S0 = jnp.zeros((bsz, HG_HEADS, HG_DK, HG_DV), jnp.float32)
    _, o = lax.scan(step, S0, (to_chunks(q, HG_DK), to_chunks(k, HG_DK),
                               to_chunks(v, HG_DV), to_chunks(log_f, HG_DK)))
    o = o.transpose(1, 0, 3, 2, 4).reshape(bsz, seqlen, HG_VAL)
    o = group_rms_norm(o, norm_w, HG_HEADS) * jax.nn.silu(g_in.astype(jnp.float32))
    return o.astype(q_raw.dtype)


def causal_depthwise_conv(u, w, b):
    ch = u.shape[-1]
    out = lax.conv_general_dilated(u, w[:, None, :].astype(u.dtype), window_strides=(1,),
                                   padding=[(SSD_CONV - 1, 0)],
                                   dimension_numbers=('NWC', 'WIO', 'NWC'),
                                   feature_group_count=ch)
    return out + b.astype(u.dtype)


def ssd_chunked(x, a, Bm, Cm):
    bsz, seqlen = x.shape[:2]
    nc = seqlen // SSD_CHUNK
    x = x.reshape(bsz, nc, SSD_CHUNK, SSD_GROUPS, SSD_HPG, SSD_HEADDIM)
    a = a.reshape(bsz, nc, SSD_CHUNK, SSD_GROUPS, SSD_HPG)
    Bm = Bm.reshape(bsz, nc, SSD_CHUNK, SSD_GROUPS, SSD_STATE)
    Cm = Cm.reshape(bsz, nc, SSD_CHUNK, SSD_GROUPS, SSD_STATE)
    a_cs = jnp.cumsum(a, axis=2)
    tril = jnp.tril(jnp.ones((SSD_CHUNK, SSD_CHUNK), dtype=bool))
    seg = jnp.where(tril[:, :, None, None], a_cs[:, :, :, None] - a_cs[:, :, None, :], -jnp.inf)
    decay_in = jnp.exp(seg)
    cb = jnp.einsum('bctgn,bcsgn->bctsg', Cm, Bm)
    y_diag = jnp.einsum('bctsgh,bcsghp->bctghp', cb[..., None] * decay_in, x)
    decay_states = jnp.exp(a_cs[:, :, -1:] - a_cs)
    states = jnp.einsum('bcsgn,bcsghp->bcghpn', Bm, x * decay_states[..., None])
    states = jnp.concatenate([jnp.zeros_like(states[:, :1]), states], axis=1)
    chunk_tot = jnp.pad(a_cs[:, :, -1], ((0, 0), (1, 0), (0, 0), (0, 0)))
    cs2 = jnp.cumsum(chunk_tot, axis=1)
    trilc = jnp.tril(jnp.ones((nc + 1, nc + 1), dtype=bool))
    seg_c = jnp.where(trilc[:, :, None, None], cs2[:, :, None] - cs2[:, None, :], -jnp.inf)
    new_states = jnp.einsum('bzcgh,bcghpn->bzghpn', jnp.exp(seg_c), states)
    prev = new_states[:, :-1]
    y_off = jnp.einsum('bctgn,bcghpn->bctghp', Cm, prev) * jnp.exp(a_cs)[..., None]
    return (y_diag + y_off).reshape(bsz, seqlen, SSD_GROUPS, SSD_HPG, SSD_HEADDIM)


def ssd_mixer(z, xbc, dt_raw, conv_w, conv_b, dt_bias, a_log, d_skip, norm_w):
    bsz, seqlen, _ = z.shape
    xbc = jax.nn.silu(causal_depthwise_conv(xbc, conv_w, conv_b)).astype(jnp.float32)
    xs = xbc[..., :SSD_WIDTH].reshape(bsz, seqlen, SSD_GROUPS, SSD_HPG, SSD_HEADDIM)
    Bm = xbc[..., SSD_WIDTH:SSD_WIDTH + SSD_GROUPS * SSD_STATE].reshape(bsz, seqlen, SSD_GROUPS, SSD_STATE)
    Cm = xbc[..., SSD_WIDTH + SSD_GROUPS * SSD_STATE:].reshape(bsz, seqlen, SSD_GROUPS, SSD_STATE)
    dt = jax.nn.softplus(dt_raw.astype(jnp.float32) + dt_bias.astype(jnp.float32))
    dt = dt.reshape(bsz, seqlen, SSD_GROUPS, SSD_HPG)
    A = -jnp.exp(a_log.astype(jnp.float32)).reshape(SSD_GROUPS, SSD_HPG)
    y = ssd_chunked(xs * dt[..., None], dt * A, Bm, Cm)
    y = y + d_skip.astype(jnp.float32).reshape(SSD_GROUPS, SSD_HPG)[:, :, None] * xs
    y = y.reshape(bsz, seqlen, SSD_WIDTH)
    y = group_rms_norm(y * jax.nn.silu(z.astype(jnp.float32)), norm_w, SSD_GROUPS)
    return y.astype(z.dtype)


def setup_inputs(seed: int = 0) -> dict:
    key = jax.random.key(seed)
    ks = jax.random.split(key, 20)
    f32 = jnp.float32

    def nrm(k, shape, scale):
        return jax.random.normal(k, shape, f32) * scale

    x = nrm(ks[0], (BATCH, SEQ, D_MODEL), 1.0)
    pre_mix_norm_w = 1.0 + nrm(ks[1], (DEPTH, D_MODEL), 0.02)
    w_in = nrm(ks[2], (DEPTH, D_MODEL, N_IN), D_MODEL ** -0.5)
    lb_logits = nrm(ks[3], (DEPTH + 1, HG_KEY), 0.5)
    conv_w = nrm(ks[4], (DEPTH, SSD_CONV, SSD_CONV_DIM), SSD_CONV ** -0.5)
    conv_b = nrm(ks[5], (DEPTH, SSD_CONV_DIM), 0.02)
    dt0 = jnp.exp(jax.random.uniform(ks[6], (DEPTH, SSD_HEADS), f32, math.log(1e-3), math.log(1e-1)))
    dt_bias = dt0 + jnp.log(-jnp.expm1(-dt0))
    a_log = jnp.log(jax.random.uniform(ks[7], (DEPTH, SSD_HEADS), f32, 1.0, 16.0))
    d_skip = 1.0 + nrm(ks[8], (DEPTH, SSD_HEADS), 0.1)
    hgrn_norm_w = 1.0 + nrm(ks[9], (DEPTH, HG_VAL), 0.02)
    ssd_norm_w = 1.0 + nrm(ks[10], (DEPTH, SSD_WIDTH), 0.02)
    w_out = nrm(ks[11], (DEPTH, D_MIX, D_MODEL), D_MIX ** -0.5)
    post_mix_norm_w = 1.0 + nrm(ks[12], (DEPTH, D_MODEL), 0.02)
    pre_ffn_norm_w = 1.0 + nrm(ks[13], (DEPTH, D_MODEL), 0.02)
    w_gate = nrm(ks[14], (DEPTH, D_MODEL, D_FF), D_MODEL ** -0.5)
    w_up = nrm(ks[15], (DEPTH, D_MODEL, D_FF), D_MODEL ** -0.5)
    w_down = nrm(ks[16], (DEPTH, D_FF, D_MODEL), D_FF ** -0.5)
    post_ffn_norm_w = 1.0 + nrm(ks[17], (DEPTH, D_MODEL), 0.02)
    return {"x": x, "pre_mix_norm_w": pre_mix_norm_w, "w_in": w_in, "lb_logits": lb_logits,
            "conv_w": conv_w, "conv_b": conv_b, "dt_bias": dt_bias, "a_log": a_log,
            "d_skip": d_skip, "hgrn_norm_w": hgrn_norm_w, "ssd_norm_w": ssd_norm_w,
            "w_out": w_out, "post_mix_norm_w": post_mix_norm_w, "pre_ffn_norm_w": pre_ffn_norm_w,
            "w_gate": w_gate, "w_up": w_up, "w_down": w_down, "post_ffn_norm_w": post_ffn_norm_w}


def reference(x, pre_mix_norm_w, w_in, lb_logits, conv_w, conv_b, dt_bias, a_log, d_skip,
              hgrn_norm_w, ssd_norm_w, w_out, post_mix_norm_w, pre_ffn_norm_w,
              w_gate, w_up, w_down, post_ffn_norm_w):
    lb_all = jnp.cumsum(jax.nn.softmax(lb_logits.astype(jnp.float32), axis=0), axis=0)
    split_pts = _split_points()
    for l in range(DEPTH):
        h = rms_norm(x, pre_mix_norm_w[l])
        proj = jnp.einsum('bld,dn->bln', h, w_in[l])
        q_raw, f_raw, i_in, g_in, z, xbc, dt_raw = jnp.split(proj, split_pts, axis=-1)
        o_a = hgrn2_mixer(q_raw, f_raw, i_in, g_in, lb_all[l], hgrn_norm_w[l])
        o_b = ssd_mixer(z, xbc, dt_raw, conv_w[l], conv_b[l], dt_bias[l], a_log[l],
                        d_skip[l], ssd_norm_w[l])
        mix = jnp.einsum('blm,md->bld', jnp.concatenate([o_a, o_b], axis=-1), w_out[l])
        x = x + rms_norm(mix, post_mix_norm_w[l])
        h = rms_norm(x, pre_ffn_norm_w[l])
        hid = jax.nn.silu(jnp.einsum('bld,df->blf', h, w_gate[l])) * jnp.einsum('bld,df->blf', h, w_up[l])
        ff = jnp.einsum('blf,fd->bld', hid, w_down[l])
        x = x + rms_norm(ff, post_ffn_norm_w[l])
    return x
```

```cpp
#include <hip/hip_runtime.h>
#include <hip/hip_cooperative_groups.h>
#include <cstdio>
#include <cstdint>
namespace cg = cooperative_groups;
namespace pg8 {
#define PG8_LAS __attribute__((address_space(3)))
typedef unsigned short bf16_t;
typedef short bf16x8 __attribute__((ext_vector_type(8)));
typedef float f32x4 __attribute__((ext_vector_type(4)));
typedef unsigned u32x4 __attribute__((ext_vector_type(4)));
constexpr int BM = 256, BK = 64, HALF = 128, HTB = HALF * BK * 2  , STAGE_BYTES = 8 * HTB, NXCD = 8, WGM = 8;

__host__ __device__ __forceinline__ int lds_byte(int r, int c) { const int st = (r >> 4) * 2 + (c >> 5), rr = r & 15, cc = c & 31, ob = rr * 64 + cc * 2; return st * 1024 + (ob ^ (((ob >> 9) & 1) << 5)); }
__host__ __device__ __forceinline__ void stage_rc(int b, int& R, int& C) { const int st = b / 1024, sb = b % 1024, swz = sb ^ (((sb >> 9) & 1) << 5); R = (st >> 1) * 16 + swz / 64; C = (st & 1) * 32 + (swz % 64) / 2; }
__host__ __device__ __forceinline__ int perm32(int rho) { const int n = rho >> 4, i = rho & 15; return 8 * (i >> 2) + 4 * n + (i & 3); }

struct Unit { int pm, pn; };
struct Gemm { const bf16_t* A; const bf16_t* Bt; int M, N, K; };

struct StaticOrder {
    int nM, nN, nwg, G, c;
    __host__ __device__ void init(int M, int N, int G_, int c_) { nM = M / BM; nN = N / BM; nwg = nM * nN; G = G_; c = c_; }
    __host__ __device__ bool next(int i, Unit& u) const {
        const long L = (long)i * G + c; if (L >= nwg) return false;
        int wgid = (int)L; { const int q = nwg / NXCD, r = nwg % NXCD, xcd = wgid % NXCD, off = wgid / NXCD; wgid = (xcd < r ? xcd * (q + 1) : r * (q + 1) + (xcd - r) * q) + off; }
        const int nig = WGM * nN, gid = wgid / nig, fm = gid * WGM, gsz = (nM - fm) < WGM ? (nM - fm) : WGM;
        u.pm = fm + ((wgid % nig) % gsz); u.pn = (wgid % nig) / gsz; return true;
    }
    __device__ __forceinline__ void a_ready(const Unit&) const {}
    __device__ __forceinline__ void done(const Unit&) const {}
};

__device__ __forceinline__ unsigned cvt_pk_bf16(float lo, float hi) { unsigned r; asm volatile("v_cvt_pk_bf16_f32 %0, %1, %2" : "=v"(r) : "v"(lo), "v"(hi)); return r; }
struct EpiBf16 {
    static constexpr bool PERM = true, AFTER_DRAIN = false;
    bf16_t* O; int ldc;
    __device__ __forceinline__ void operator()(const f32x4 (&acc)[2][2][4][2], const Unit& u, int wr, int wc, int fr, int fq) const {
        const int row0 = u.pm * BM + wr * 64 + fr; const int col0 = u.pn * BM + wc * 32 + 8 * fq;
#pragma unroll
        for (int ai = 0; ai < 2; ++ai)
#pragma unroll
            for (int m = 0; m < 4; ++m) { bf16_t* rowp = O + (size_t)(row0 + ai * HALF + m * 16) * ldc + col0;
#pragma unroll
                for (int bj = 0; bj < 2; ++bj) { const f32x4 v0 = acc[ai][bj][m][0], v1 = acc[ai][bj][m][1];
                    u32x4 w; w.x = cvt_pk_bf16(v0[0], v0[1]); w.y = cvt_pk_bf16(v0[2], v0[3]); w.z = cvt_pk_bf16(v1[0], v1[1]); w.w = cvt_pk_bf16(v1[2], v1[3]);
                    *(u32x4*)(rowp + bj * HALF) = w; } }
    }
};
__device__ __forceinline__ float silu_f(float v) { return v / (1.0f + __expf(-v)); }
struct EpiSwiglu {
    static constexpr bool PERM = true, AFTER_DRAIN = false;
    bf16_t* O; int ldc;
    __device__ __forceinline__ void operator()(const f32x4 (&acc)[2][2][4][2], const Unit& u, int wr, int wc, int fr, int fq) const {
        const int row0 = u.pm * BM + wr * 64 + fr; const int col0 = u.pn * HALF + wc * 32 + 8 * fq;
#pragma unroll
        for (int ai = 0; ai < 2; ++ai)
#pragma unroll
            for (int m = 0; m < 4; ++m) { bf16_t* rowp = O + (size_t)(row0 + ai * HALF + m * 16) * ldc + col0;
                const f32x4 g0 = acc[ai][0][m][0], g1 = acc[ai][0][m][1], u0 = acc[ai][1][m][0], u1 = acc[ai][1][m][1];
                u32x4 w; w.x = cvt_pk_bf16(silu_f(g0[0]) * u0[0], silu_f(g0[1]) * u0[1]); w.y = cvt_pk_bf16(silu_f(g0[2]) * u0[2], silu_f(g0[3]) * u0[3]);
                w.z = cvt_pk_bf16(silu_f(g1[0]) * u1[0], silu_f(g1[1]) * u1[1]); w.w = cvt_pk_bf16(silu_f(g1[2]) * u1[2], silu_f(g1[3]) * u1[3]);
                *(u32x4*)rowp = w; }
    }
};

template <class Epi, class Sched, bool ALIGN_EPI = false, bool SP2 = false>
__device__ __forceinline__ void gemm_phase(PG8_LAS unsigned char* lds, const Gemm g, const Sched& S, const Epi& E) {
    const int tid = threadIdx.x, wid = __builtin_amdgcn_readfirstlane(tid >> 6), lane = tid & 63, wr = wid >> 2, wc = wid & 3, fr = lane & 15, fq = lane >> 4;
    const int K = g.K, nt = K / BK;
    unsigned voffA[2], voffB[2];
#pragma unroll
    for (int i = 0; i < 2; ++i) { int R, C; stage_rc(tid * 16 + i * 8192, R, C); const int Rb = Epi::PERM ? ((R & ~31) + perm32(R & 31)) : R;
        voffA[i] = (unsigned)(R * K + C) * 2u; voffB[i] = (unsigned)(Rb * K + C) * 2u; }
    const size_t kstep = (size_t)(BK * 2);
    const size_t hstep = (size_t)HALF * K * 2;
    const size_t tstep = 2 * hstep;
    const unsigned ldsw = (unsigned)wid * 1024u;
    const int aoff = lds_byte(wr * 64 + fr, fq * 8), boff = lds_byte(wc * 32 + fr, fq * 8);
#define PG8_SA(b, h) (((b) * 2 + (h)) * HTB)
#define PG8_SB(b, h) ((4 + (b) * 2 + (h)) * HTB)
#define PG8_STAGE(bufoff, gbase, voff) do { _Pragma("unroll") for (int _i = 0; _i < 2; ++_i) \
        __builtin_amdgcn_global_load_lds((const unsigned*)((const char*)(gbase) + (voff)[_i]), (PG8_LAS unsigned*)(lds + (bufoff) + ldsw + _i * 8192), 16, 0, 0); } while (0)
#define PG8_LDA(dst, b, h) do { _Pragma("unroll") for (int m = 0; m < 4; ++m) _Pragma("unroll") for (int k = 0; k < 2; ++k) dst[m][k] = *(const PG8_LAS bf16x8*)(lds + PG8_SA(b, h) + aoff + m * 2048 + k * 1024); } while (0)
#define PG8_LDB(dst, b, h) do { _Pragma("unroll") for (int n = 0; n < 2; ++n) _Pragma("unroll") for (int k = 0; k < 2; ++k) dst[n][k] = *(const PG8_LAS bf16x8*)(lds + PG8_SB(b, h) + boff + n * 2048 + k * 1024); } while (0)
#define PG8_MMA(ai, bj, At, Bt) do { __builtin_amdgcn_s_setprio(1); _Pragma("unroll") for (int m = 0; m < 4; ++m) _Pragma("unroll") for (int n = 0; n < 2; ++n) _Pragma("unroll") for (int k = 0; k < 2; ++k) \
        acc[ai][bj][m][n] = __builtin_amdgcn_mfma_f32_16x16x32_bf16(Bt[n][k], At[m][k], acc[ai][bj][m][n], 0, 0, 0); __builtin_amdgcn_s_setprio(0); } while (0)
#define PG8_WAIT_V(n) asm volatile("s_waitcnt vmcnt(" #n ")" ::: "memory")
#define PG8_WAIT_L(n) asm volatile("s_waitcnt lgkmcnt(" #n ")" ::: "memory")
#define PG8_BAR __builtin_amdgcn_s_barrier()
#define PG8_SCHED __builtin_amdgcn_sched_barrier(0)
    Unit cur, nxt; int ui = 0;
    if (!S.next(0, cur)) return;
    f32x4 acc[2][2][4][2];
#pragma unroll
    for (int a = 0; a < 2; ++a)
#pragma unroll
        for (int b = 0; b < 2; ++b)
#pragma unroll
            for (int m = 0; m < 4; ++m)
#pragma unroll
                for (int n = 0; n < 2; ++n) acc[a][b][m][n] = (f32x4){0.f, 0.f, 0.f, 0.f};
    bf16x8 At[4][2], B0[2][2], B1[2][2];
    const char* cA = (const char*)g.A + (size_t)cur.pm * tstep; const char* cB = (const char*)g.Bt + (size_t)cur.pn * tstep;
    S.a_ready(cur);
    if constexpr (SP2) {
        PG8_STAGE(PG8_SB(0, 0), cB, voffB); PG8_STAGE(PG8_SB(0, 1), cB + hstep, voffB); PG8_STAGE(PG8_SA(0, 0), cA, voffA); PG8_STAGE(PG8_SA(0, 1), cA + hstep, voffA);
        if (wr == 1) PG8_BAR;
        PG8_WAIT_V(2); PG8_BAR;
        PG8_STAGE(PG8_SB(1, 0), cB + kstep, voffB); PG8_STAGE(PG8_SA(1, 0), cA + kstep, voffA); PG8_STAGE(PG8_SB(1, 1), cB + hstep + kstep, voffB);
        PG8_WAIT_V(6); PG8_BAR;
    } else {
        PG8_STAGE(PG8_SB(0, 0), cB, voffB); PG8_STAGE(PG8_SA(0, 0), cA, voffA); PG8_STAGE(PG8_SB(0, 1), cB + hstep, voffB); PG8_STAGE(PG8_SA(0, 1), cA + hstep, voffA);
        if (wr == 1) PG8_BAR;
        PG8_WAIT_V(4); PG8_BAR;
        PG8_STAGE(PG8_SB(1, 0), cB + kstep, voffB); PG8_STAGE(PG8_SA(1, 0), cA + kstep, voffA); PG8_STAGE(PG8_SB(1, 1), cB + hstep + kstep, voffB);
        PG8_WAIT_V(6); PG8_BAR;
    }
    for (;;) {
        const bool has_next = S.next(ui + 1, nxt);
        const char* nA = has_next ? (const char*)g.A + (size_t)nxt.pm * tstep : cA; const char* nB = has_next ? (const char*)g.Bt + (size_t)nxt.pn * tstep : cB;
        for (int t = 0; t < nt; t += 2) {
            const bool last = (t == nt - 2);
            const char* a1 = cA + (size_t)(t + 1) * kstep;
            const char* a2 = last ? nA : cA + (size_t)(t + 2) * kstep; const char* b2 = last ? nB : cB + (size_t)(t + 2) * kstep;
            const char* a3 = a2 + kstep; const char* b3 = b2 + kstep;
            if (last && has_next) S.a_ready(nxt);
            if constexpr (SP2) {
            PG8_LDB(B0, 0, 0); PG8_LDB(B1, 0, 1); PG8_SCHED; PG8_LDA(At, 0, 0); PG8_STAGE(PG8_SA(1, 1), a1 + hstep, voffA);
            PG8_WAIT_V(8); PG8_WAIT_L(0); PG8_BAR; PG8_MMA(0, 0, At, B0); PG8_MMA(0, 1, At, B1); PG8_BAR; PG8_SCHED;
            PG8_LDA(At, 0, 1); PG8_STAGE(PG8_SB(0, 0), b2, voffB); PG8_STAGE(PG8_SB(0, 1), b2 + hstep, voffB); PG8_STAGE(PG8_SA(0, 0), a2, voffA);
            PG8_WAIT_V(8); PG8_WAIT_L(0); PG8_BAR; PG8_MMA(1, 0, At, B0); PG8_MMA(1, 1, At, B1); PG8_BAR; PG8_SCHED;
            PG8_LDB(B0, 1, 0); PG8_LDB(B1, 1, 1); PG8_SCHED; PG8_LDA(At, 1, 0); PG8_STAGE(PG8_SA(0, 1), a2 + hstep, voffA);
            PG8_WAIT_V(8); PG8_WAIT_L(0); PG8_BAR; PG8_MMA(0, 0, At, B0); PG8_MMA(0, 1, At, B1); PG8_BAR; PG8_SCHED;
            PG8_LDA(At, 1, 1); PG8_STAGE(PG8_SB(1, 0), b3, voffB); PG8_STAGE(PG8_SB(1, 1), b3 + hstep, voffB); PG8_STAGE(PG8_SA(1, 0), a3, voffA);
            PG8_WAIT_V(8); PG8_WAIT_L(0); PG8_BAR; PG8_MMA(1, 0, At, B0); PG8_MMA(1, 1, At, B1); PG8_BAR; PG8_SCHED;
            } else {
            PG8_LDB(B0, 0, 0); PG8_SCHED; PG8_LDA(At, 0, 0); PG8_STAGE(PG8_SA(1, 1), a1 + hstep, voffA);
            PG8_WAIT_L(8); PG8_BAR; PG8_WAIT_L(0); PG8_MMA(0, 0, At, B0); PG8_BAR; PG8_SCHED;
            PG8_LDB(B1, 0, 1); PG8_STAGE(PG8_SB(0, 0), b2, voffB);
            PG8_BAR; PG8_WAIT_L(0); PG8_MMA(0, 1, At, B1); PG8_BAR;
            PG8_LDA(At, 0, 1); PG8_STAGE(PG8_SA(0, 0), a2, voffA);
            PG8_BAR; PG8_WAIT_L(0); PG8_MMA(1, 0, At, B0); PG8_BAR; PG8_SCHED;
            PG8_STAGE(PG8_SB(0, 1), b2 + hstep, voffB);
            PG8_WAIT_V(6); PG8_BAR; PG8_MMA(1, 1, At, B1); PG8_BAR;
            PG8_LDB(B0, 1, 0); PG8_SCHED; PG8_LDA(At, 1, 0); PG8_STAGE(PG8_SA(0, 1), a2 + hstep, voffA);
            PG8_WAIT_L(8); PG8_BAR; PG8_WAIT_L(0); PG8_MMA(0, 0, At, B0); PG8_BAR; PG8_SCHED;
            PG8_LDB(B1, 1, 1); PG8_STAGE(PG8_SB(1, 0), b3, voffB);
            PG8_BAR; PG8_WAIT_L(0); PG8_MMA(0, 1, At, B1); PG8_BAR;
            PG8_LDA(At, 1, 1); PG8_STAGE(PG8_SA(1, 0), a3, voffA);
            PG8_BAR; PG8_WAIT_L(0); PG8_MMA(1, 0, At, B0); PG8_BAR; PG8_SCHED;
            PG8_STAGE(PG8_SB(1, 1), b3 + hstep, voffB);
            PG8_WAIT_V(6); PG8_BAR; PG8_MMA(1, 1, At, B1); PG8_BAR;
            }
        }
        if constexpr (ALIGN_EPI) { if (wr == 0) PG8_BAR; }
        if constexpr (!Epi::AFTER_DRAIN) { E(acc, cur, wr, wc, fr, fq); S.done(cur); }
        if (!has_next) break;
#pragma unroll
        for (int a = 0; a < 2; ++a)
#pragma unroll
            for (int b = 0; b < 2; ++b)
#pragma unroll
                for (int m = 0; m < 4; ++m)
#pragma unroll
                    for (int n = 0; n < 2; ++n) acc[a][b][m][n] = (f32x4){0.f, 0.f, 0.f, 0.f};
        cur = nxt; cA = nA; cB = nB; ++ui;
        if constexpr (ALIGN_EPI) { if (wr == 1) PG8_BAR; }
    }
    PG8_WAIT_V(0);
    if constexpr (!ALIGN_EPI) { if (wr == 0) PG8_BAR; }
    PG8_BAR;
    if constexpr (Epi::AFTER_DRAIN) { E.fused(acc, cur, wr, wc, fr, fq, lds, wid, lane); S.done(cur); }
#undef PG8_SA
#undef PG8_SB
#undef PG8_STAGE
#undef PG8_LDA
#undef PG8_LDB
#undef PG8_MMA
#undef PG8_WAIT_V
#undef PG8_WAIT_L
#undef PG8_BAR
#undef PG8_SCHED
}
}

constexpr int BATCH = 2, SEQ = 8192, M = BATCH * SEQ, D = 2048;
constexpr int NIN = 6672, NINP = 6912, DFF = 5632, NGU = 2 * DFF;
constexpr int C_Q = 0, C_F = 1024, C_I = 2048, C_G = 3072, C_Z = 4096, C_XBC = 5120, C_DT = 6656;
constexpr int XBC_W = 1536;
constexpr float EPS = 1e-6f;
constexpr size_t MiB = 1u << 20;
constexpr size_t WS_WIN = 1 * MiB;
constexpr size_t WS_WOUT = 28 * MiB;
constexpr size_t WS_WGU = 36 * MiB;
constexpr size_t WS_WDN = 80 * MiB;
constexpr size_t WS_XN = 102 * MiB;
constexpr size_t WS_PROJ = 166 * MiB;
constexpr size_t WS_ST = 382 * MiB;
constexpr size_t WS_DEC = 478 * MiB;
constexpr size_t WS_END = 480 * MiB;
constexpr int LDS_BYTES = 147456;

#define LAS __attribute__((address_space(3)))
typedef unsigned short bf16;
typedef float f32x4 __attribute__((ext_vector_type(4)));
typedef unsigned u32x4 __attribute__((ext_vector_type(4)));
#define LDS_WAIT() asm volatile("s_waitcnt lgkmcnt(0)" ::: "memory")
__device__ __forceinline__ float bf2f(unsigned short u) { return __uint_as_float(((unsigned)u) << 16); }
__device__ __forceinline__ unsigned f2bf(float f) { unsigned u = __float_as_uint(f); return (u + 0x7fffu + ((u >> 16) & 1u)) >> 16; }
__device__ __forceinline__ unsigned pk2(float lo, float hi) { return f2bf(lo) | (f2bf(hi) << 16); }
__device__ __forceinline__ float bflo(unsigned w) { return __uint_as_float(w << 16); }
__device__ __forceinline__ float bfhi(unsigned w) { return __uint_as_float(w & 0xffff0000u); }
__device__ __forceinline__ float wave_sum(float v) {
#pragma unroll
    for (int o = 1; o < 64; o <<= 1) v += __shfl_xor(v, o);
    return v;
}
__device__ __forceinline__ float sigm(float x) { return 1.0f / (1.0f + __expf(-x)); }
__device__ __forceinline__ float silu(float x) { return x / (1.0f + __expf(-x)); }

struct Params {
    const float *x, *pre_mix_w, *w_in, *lb_logits, *conv_w, *conv_b, *dt_bias, *a_log, *d_skip, *hgrn_nw, *ssd_nw, *w_out, *post_mix_w, *pre_ffn_w, *w_gate, *w_up, *w_down, *post_ffn_w;
    float* out; unsigned char* ws;
};

__device__ __forceinline__ void transpose_item(const float* W, int K, int N, bf16* WT, int k0, int n0, int rowb, LAS float* scr, int lane) {
    const int n_in = n0 + (lane & 31);
#pragma unroll 8
    for (int i = 0; i < 32; ++i) { const int kk = 2 * i + (lane >> 5); scr[kk * 33 + (lane & 31)] = (n_in < N) ? W[(size_t)(k0 + kk) * N + n_in] : 0.f; }
    LDS_WAIT();
    const int c = lane & 7;
#pragma unroll
    for (int j = 0; j < 4; ++j) { const int n = (lane >> 3) + 8 * j; const LAS float* s = scr + (8 * c) * 33 + n;
        u32x4 o; o.x = pk2(s[0 * 33], s[1 * 33]); o.y = pk2(s[2 * 33], s[3 * 33]); o.z = pk2(s[4 * 33], s[5 * 33]); o.w = pk2(s[6 * 33], s[7 * 33]);
        *(u32x4*)(WT + (size_t)(rowb + n) * K + k0 + 8 * c) = o; }
    LDS_WAIT();
}
__device__ __forceinline__ void rms_row_to_bf16(const float* xrow, const float* w, bf16* orow, int lane) {
    f32x4 v[8]; float ss = 0.f;
#pragma unroll
    for (int j = 0; j < 4; ++j) { const int base = 8 * (lane + 64 * j); v[2 * j] = *(const f32x4*)(xrow + base); v[2 * j + 1] = *(const f32x4*)(xrow + base + 4);
        const f32x4 a = v[2 * j], b = v[2 * j + 1]; ss += (a.x * a.x + a.y * a.y) + (a.z * a.z + a.w * a.w) + (b.x * b.x + b.y * b.y) + (b.z * b.z + b.w * b.w); }
    const float r = rsqrtf(wave_sum(ss) * (1.0f / D) + EPS);
#pragma unroll
    for (int j = 0; j < 4; ++j) { const int base = 8 * (lane + 64 * j); const f32x4 w0 = *(const f32x4*)(w + base), w1 = *(const f32x4*)(w + base + 4); const f32x4 a = v[2 * j], b = v[2 * j + 1];
        u32x4 o; o.x = pk2(a.x * r * w0.x, a.y * r * w0.y); o.y = pk2(a.z * r * w0.z, a.w * r * w0.w); o.z = pk2(b.x * r * w1.x, b.y * r * w1.y); o.w = pk2(b.z * r * w1.z, b.w * r * w1.w);
        *(u32x4*)(orow + base) = o; }
}

__device__ __forceinline__ void naive_hgrn(LAS unsigned char* lds, const Params& p, int bh) {
    const int tid = threadIdx.x, lane = tid & 63, wave = tid >> 6, quarter = tid >> 7, v = tid & 127;
    const int b = bh >> 3, h = bh & 7;
    const bf16* proj = (const bf16*)(p.ws + WS_PROJ); bf16* mixin = (bf16*)(p.ws + WS_XN);
    LAS float* fq = (LAS float*)lds; LAS float* qq = fq + 2048; LAS float* part = qq + 2048;
    float S[32];
#pragma unroll
    for (int i = 0; i < 32; ++i) S[i] = 0.f;
    for (int t0 = 0; t0 < SEQ; t0 += 16) {
        const size_t rowb = (size_t)b * SEQ + t0;
        for (int e = tid; e < 2048; e += 512) { const int tt = e >> 7, k = e & 127; const bf16* pr = proj + (rowb + tt) * NINP + h * 128 + k;
            const float qr = bf2f(pr[C_Q]), fr = bf2f(pr[C_F]); const float l0 = p.lb_logits[h * 128 + k], l1 = p.lb_logits[1024 + h * 128 + k]; const float lb = 1.0f / (1.0f + expf(l1 - l0));
            fq[e] = lb + (1.0f - lb) * sigm(fr); qq[e] = silu(qr) * 0.08838834764831845f; }
        __syncthreads();
        for (int tt = 0; tt < 16; ++tt) { const float iv = bf2f(proj[(rowb + tt) * NINP + C_I + h * 128 + v]); float acc = 0.f;
#pragma unroll
            for (int kk = 0; kk < 32; ++kk) { const float f = fq[tt * 128 + quarter * 32 + kk]; S[kk] = f * S[kk] + (1.0f - f) * iv; acc += S[kk] * qq[tt * 128 + quarter * 32 + kk]; }
            part[(quarter * 16 + tt) * 128 + v] = acc; }
        __syncthreads();
        for (int tt = 2 * wave; tt < 2 * wave + 2; ++tt) {
            float o0 = 0.f, o1 = 0.f;
#pragma unroll
            for (int q = 0; q < 4; ++q) { o0 += part[(q * 16 + tt) * 128 + lane]; o1 += part[(q * 16 + tt) * 128 + 64 + lane]; }
            const float r = rsqrtf(wave_sum(o0 * o0 + o1 * o1) * (1.0f / 128.0f) + EPS);
            const bf16* pr = proj + (rowb + tt) * NINP + C_G + h * 128; const float g0 = bf2f(pr[lane]), g1 = bf2f(pr[64 + lane]);
            bf16* mo = mixin + (rowb + tt) * 2048 + h * 128;
            mo[lane] = (bf16)f2bf(o0 * r * p.hgrn_nw[h * 128 + lane] * silu(g0)); mo[64 + lane] = (bf16)f2bf(o1 * r * p.hgrn_nw[h * 128 + 64 + lane] * silu(g1));
        }
        __syncthreads();
    }
}
__device__ __forceinline__ void naive_ssd(LAS unsigned char* lds, const Params& p, int bg) {
    const int tid = threadIdx.x, lane = tid & 63, wave = tid >> 6;
    const int b = bg >> 1, g = bg & 1, hh = wave, head = g * 8 + hh, pp = lane;
    const bf16* proj = (const bf16*)(p.ws + WS_PROJ); bf16* mixin = (bf16*)(p.ws + WS_XN);
    LAS float* Bs = (LAS float*)lds; LAS float* Cs = Bs + 2048; LAS float* xs = Cs + 2048; LAS float* yb = xs + 8192; LAS float* dtl = yb + 8192;
    float hst[128];
#pragma unroll
    for (int i = 0; i < 128; ++i) hst[i] = 0.f;
    const float A = -expf(p.a_log[head]), Dk = p.d_skip[head];
    for (int t0 = 0; t0 < SEQ; t0 += 16) {
        const size_t rowb = (size_t)b * SEQ + t0;
        for (int e = tid; e < 16 * 768; e += 512) { const int tt = e / 768, ch = e - tt * 768;
            const int col = ch < 512 ? g * 512 + ch : (ch < 640 ? 1024 + g * 128 + (ch - 512) : 1280 + g * 128 + (ch - 640));
            float acc = p.conv_b[col];
#pragma unroll
            for (int kk = 0; kk < 4; ++kk) { const int ts = t0 + tt - 3 + kk; if (ts >= 0) acc += p.conv_w[kk * XBC_W + col] * bf2f(proj[((size_t)b * SEQ + ts) * NINP + C_XBC + col]); }
            const float val = silu(acc);
            if (ch < 512) xs[tt * 512 + ch] = val; else if (ch < 640) Bs[tt * 128 + ch - 512] = val; else Cs[tt * 128 + ch - 640] = val; }
        if (tid < 128) { const int tt = tid >> 3, h8 = tid & 7; const float xr = bf2f(proj[(rowb + tt) * NINP + C_DT + g * 8 + h8]) + p.dt_bias[g * 8 + h8]; dtl[tid] = xr > 20.f ? xr : log1pf(expf(xr)); }
        __syncthreads();
        for (int tt = 0; tt < 16; ++tt) { const float dt = dtl[tt * 8 + hh], dA = expf(dt * A), xv = xs[tt * 512 + hh * 64 + pp], xdt = xv * dt; float y = 0.f;
#pragma unroll
            for (int n = 0; n < 128; ++n) { hst[n] = dA * hst[n] + xdt * Bs[tt * 128 + n]; y += Cs[tt * 128 + n] * hst[n]; }
            y += Dk * xv; const float z = bf2f(proj[(rowb + tt) * NINP + C_Z + head * 64 + pp]); yb[tt * 512 + hh * 64 + pp] = y * silu(z); }
        __syncthreads();
        for (int tt = 2 * wave; tt < 2 * wave + 2; ++tt) {
            float yv[8]; float ss = 0.f;
#pragma unroll
            for (int j = 0; j < 8; ++j) { yv[j] = yb[tt * 512 + lane + 64 * j]; ss += yv[j] * yv[j]; }
            const float r = rsqrtf(wave_sum(ss) * (1.0f / 512.0f) + EPS);
            bf16* mo = mixin + (rowb + tt) * 2048 + 1024 + g * 512;
#pragma unroll
            for (int j = 0; j < 8; ++j) mo[lane + 64 * j] = (bf16)f2bf(yv[j] * r * p.ssd_nw[g * 512 + lane + 64 * j]);
        }
        __syncthreads();
    }
}

__global__ void __launch_bounds__(512) fwd_kernel(Params p) {
    extern __shared__ __attribute__((aligned(16))) unsigned char lds_raw[];
    LAS unsigned char* lds = (LAS unsigned char*)lds_raw;
    cg::grid_group grid = cg::this_grid();
    const int tid = threadIdx.x, lane = tid & 63, wave = __builtin_amdgcn_readfirstlane(tid >> 6);
    const int G = gridDim.x, gw = blockIdx.x * 8 + wave, NGW = G * 8;
    bf16* WIN = (bf16*)(p.ws + WS_WIN); bf16* WOUT = (bf16*)(p.ws + WS_WOUT); bf16* WGU = (bf16*)(p.ws + WS_WGU); bf16* WDN = (bf16*)(p.ws + WS_WDN);
    bf16* XN = (bf16*)(p.ws + WS_XN); bf16* PROJ = (bf16*)(p.ws + WS_PROJ); bf16* HID = (bf16*)(p.ws + WS_PROJ); bf16* MIXO = (bf16*)(p.ws + WS_ST); bf16* FF = (bf16*)(p.ws + WS_ST);

    {
        LAS float* scr = (LAS float*)(lds + wave * 16384);
        constexpr int I_IN = 32 * (NINP / 32), I_OUT = 32 * (D / 32), I_G = 32 * (DFF / 32), I_DN = (DFF / 64) * (D / 32);
        constexpr int NITEMS = I_IN + I_OUT + 2 * I_G + I_DN;
        for (int it = gw; it < NITEMS; it += NGW) {
            int r = it;
            if (r < I_IN) { const int nb = NINP / 32, kb = r / nb, n0 = 32 * (r % nb); transpose_item(p.w_in, D, NIN, WIN, 64 * kb, n0, n0, scr, lane); continue; } r -= I_IN;
            if (r < I_OUT) { const int nb = D / 32, kb = r / nb, n0 = 32 * (r % nb); transpose_item(p.w_out, D, D, WOUT, 64 * kb, n0, n0, scr, lane); continue; } r -= I_OUT;
            if (r < I_G) { const int nb = DFF / 32, kb = r / nb, n0 = 32 * (r % nb); transpose_item(p.w_gate, D, DFF, WGU, 64 * kb, n0, 256 * (n0 >> 7) + (n0 & 127), scr, lane); continue; } r -= I_G;
            if (r < I_G) { const int nb = DFF / 32, kb = r / nb, n0 = 32 * (r % nb); transpose_item(p.w_up, D, DFF, WGU, 64 * kb, n0, 256 * (n0 >> 7) + 128 + (n0 & 127), scr, lane); continue; } r -= I_G;
            { const int nb = D / 32, kb = r / nb, n0 = 32 * (r % nb); transpose_item(p.w_down, DFF, D, WDN, 64 * kb, n0, n0, scr, lane); }
        }
        for (int m = gw; m < M; m += NGW) rms_row_to_bf16(p.x + (size_t)m * D, p.pre_mix_w, XN + (size_t)m * D, lane);
    }
    grid.sync();
    {
        pg8::Gemm g{XN, WIN, M, NINP, D}; pg8::StaticOrder S; S.init(M, NINP, G, (int)blockIdx.x); pg8::EpiBf16 E{PROJ, NINP};
        pg8::gemm_phase<pg8::EpiBf16, pg8::StaticOrder, true, true>(lds, g, S, E);
    }
    grid.sync();
    if (blockIdx.x < 16) naive_hgrn(lds, p, (int)blockIdx.x);
    else if (blockIdx.x < 20) naive_ssd(lds, p, (int)blockIdx.x - 16);
    grid.sync();
    {
        pg8::Gemm g{XN, WOUT, M, D, D}; pg8::StaticOrder S; S.init(M, D, G, (int)blockIdx.x); pg8::EpiBf16 E{MIXO, D};
        pg8::gemm_phase<pg8::EpiBf16, pg8::StaticOrder, true, true>(lds, g, S, E);
    }
    grid.sync();
    for (int m = gw; m < M; m += NGW) {
        const float* xr = p.x + (size_t)m * D; const bf16* mr = MIXO + (size_t)m * D; float* orow = p.out + (size_t)m * D; bf16* xn = XN + (size_t)m * D;
        u32x4 mw[4]; float ss = 0.f;
#pragma unroll
        for (int j = 0; j < 4; ++j) { mw[j] = *(const u32x4*)(mr + 8 * (lane + 64 * j));
            const float a0 = bflo(mw[j].x), a1 = bfhi(mw[j].x), a2 = bflo(mw[j].y), a3 = bfhi(mw[j].y), a4 = bflo(mw[j].z), a5 = bfhi(mw[j].z), a6 = bflo(mw[j].w), a7 = bfhi(mw[j].w);
            ss += (a0 * a0 + a1 * a1) + (a2 * a2 + a3 * a3) + (a4 * a4 + a5 * a5) + (a6 * a6 + a7 * a7); }
        const float r1 = rsqrtf(wave_sum(ss) * (1.0f / D) + EPS);
        f32x4 x1[8]; float ss1 = 0.f;
#pragma unroll
        for (int j = 0; j < 4; ++j) { const int base = 8 * (lane + 64 * j);
            const f32x4 xa = *(const f32x4*)(xr + base), xb = *(const f32x4*)(xr + base + 4), wa = *(const f32x4*)(p.post_mix_w + base), wb = *(const f32x4*)(p.post_mix_w + base + 4);
            f32x4 a, b2;
            a.x = xa.x + bflo(mw[j].x) * r1 * wa.x; a.y = xa.y + bfhi(mw[j].x) * r1 * wa.y; a.z = xa.z + bflo(mw[j].y) * r1 * wa.z; a.w = xa.w + bfhi(mw[j].y) * r1 * wa.w;
            b2.x = xb.x + bflo(mw[j].z) * r1 * wb.x; b2.y = xb.y + bfhi(mw[j].z) * r1 * wb.y; b2.z = xb.z + bflo(mw[j].w) * r1 * wb.z; b2.w = xb.w + bfhi(mw[j].w) * r1 * wb.w;
            x1[2 * j] = a; x1[2 * j + 1] = b2; *(f32x4*)(orow + base) = a; *(f32x4*)(orow + base + 4) = b2;
            ss1 += (a.x * a.x + a.y * a.y) + (a.z * a.z + a.w * a.w) + (b2.x * b2.x + b2.y * b2.y) + (b2.z * b2.z + b2.w * b2.w); }
        const float r2 = rsqrtf(wave_sum(ss1) * (1.0f / D) + EPS);
#pragma unroll
        for (int j = 0; j < 4; ++j) { const int base = 8 * (lane + 64 * j); const f32x4 w0 = *(const f32x4*)(p.pre_ffn_w + base), w1 = *(const f32x4*)(p.pre_ffn_w + base + 4); const f32x4 a = x1[2 * j], b2 = x1[2 * j + 1];
            u32x4 o; o.x = pk2(a.x * r2 * w0.x, a.y * r2 * w0.y); o.y = pk2(a.z * r2 * w0.z, a.w * r2 * w0.w); o.z = pk2(b2.x * r2 * w1.x, b2.y * r2 * w1.y); o.w = pk2(b2.z * r2 * w1.z, b2.w * r2 * w1.w);
            *(u32x4*)(xn + base) = o; }
    }
    grid.sync();
    {
        pg8::Gemm g{XN, WGU, M, NGU, D}; pg8::StaticOrder S; S.init(M, NGU, G, (int)blockIdx.x); pg8::EpiSwiglu E{HID, DFF};
        pg8::gemm_phase<pg8::EpiSwiglu, pg8::StaticOrder, true, true>(lds, g, S, E);
    }
    grid.sync();
    {
        pg8::Gemm g{HID, WDN, M, D, DFF}; pg8::StaticOrder S; S.init(M, D, G, (int)blockIdx.x); pg8::EpiBf16 E{FF, D};
        pg8::gemm_phase<pg8::EpiBf16, pg8::StaticOrder, true, true>(lds, g, S, E);
    }
    grid.sync();
    for (int m = gw; m < M; m += NGW) {
        const bf16* fr = FF + (size_t)m * D; float* orow = p.out + (size_t)m * D;
        u32x4 mw[4]; float ss = 0.f;
#pragma unroll
        for (int j = 0; j < 4; ++j) { mw[j] = *(const u32x4*)(fr + 8 * (lane + 64 * j));
            const float a0 = bflo(mw[j].x), a1 = bfhi(mw[j].x), a2 = bflo(mw[j].y), a3 = bfhi(mw[j].y), a4 = bflo(mw[j].z), a5 = bfhi(mw[j].z), a6 = bflo(mw[j].w), a7 = bfhi(mw[j].w);
            ss += (a0 * a0 + a1 * a1) + (a2 * a2 + a3 * a3) + (a4 * a4 + a5 * a5) + (a6 * a6 + a7 * a7); }
        const float r1 = rsqrtf(wave_sum(ss) * (1.0f / D) + EPS);
#pragma unroll
        for (int j = 0; j < 4; ++j) { const int base = 8 * (lane + 64 * j);
            const f32x4 xa = *(const f32x4*)(orow + base), xb = *(const f32x4*)(orow + base + 4), wa = *(const f32x4*)(p.post_ffn_w + base), wb = *(const f32x4*)(p.post_ffn_w + base + 4);
            f32x4 a, b2;
            a.x = xa.x + bflo(mw[j].x) * r1 * wa.x; a.y = xa.y + bfhi(mw[j].x) * r1 * wa.y; a.z = xa.z + bflo(mw[j].y) * r1 * wa.z; a.w = xa.w + bfhi(mw[j].y) * r1 * wa.w;
            b2.x = xb.x + bflo(mw[j].z) * r1 * wb.x; b2.y = xb.y + bfhi(mw[j].z) * r1 * wb.y; b2.z = xb.z + bflo(mw[j].w) * r1 * wb.z; b2.w = xb.w + bfhi(mw[j].w) * r1 * wb.w;
            *(f32x4*)(orow + base) = a; *(f32x4*)(orow + base + 4) = b2; }
    }
}

extern "C" void kernel_launch(void* const* d_in, const int* in_sizes, int n_in, void* d_out, int out_size, void* d_ws, size_t ws_size, hipStream_t stream) {
    static int grid = 0;
    if (grid == 0) {
        if (n_in != 18 || in_sizes[0] != M * D || out_size != M * D || ws_size < WS_END) { fprintf(stderr, "kernel_launch: unexpected shapes (n_in %d, in0 %d, out %d, ws %zu)\n", n_in, n_in > 0 ? in_sizes[0] : -1, out_size, ws_size); grid = -1; return; }
        int dev = 0, cus = 0, per_cu = 0;
        if (hipGetDevice(&dev) != hipSuccess || hipDeviceGetAttribute(&cus, hipDeviceAttributeMultiprocessorCount, dev) != hipSuccess) { grid = -1; return; }
        if (hipFuncSetAttribute((const void*)fwd_kernel, hipFuncAttributeMaxDynamicSharedMemorySize, LDS_BYTES) != hipSuccess) { fprintf(stderr, "kernel_launch: hipFuncSetAttribute failed\n"); grid = -1; return; }
        if (hipOccupancyMaxActiveBlocksPerMultiprocessor(&per_cu, (const void*)fwd_kernel, 512, LDS_BYTES) != hipSuccess || per_cu < 1) { fprintf(stderr, "kernel_launch: occupancy query says %d\n", per_cu); per_cu = 1; }
        (void)hipGetLastError();
        grid = cus;
    }
    if (grid < 0) return;
    Params p{};
    p.x = (const float*)d_in[0]; p.pre_mix_w = (const float*)d_in[1]; p.w_in = (const float*)d_in[2]; p.lb_logits = (const float*)d_in[3]; p.conv_w = (const float*)d_in[4]; p.conv_b = (const float*)d_in[5];
    p.dt_bias = (const float*)d_in[6]; p.a_log = (const float*)d_in[7]; p.d_skip = (const float*)d_in[8]; p.hgrn_nw = (const float*)d_in[9]; p.ssd_nw = (const float*)d_in[10]; p.w_out = (const float*)d_in[11];
    p.post_mix_w = (const float*)d_in[12]; p.pre_ffn_w = (const float*)d_in[13]; p.w_gate = (const float*)d_in[14]; p.w_up = (const float*)d_in[15]; p.w_down = (const float*)d_in[16]; p.post_ffn_w = (const float*)d_in[17];
    p.out = (float*)d_out; p.ws = (unsigned char*)d_ws;
    void* args[] = {&p};
    hipError_t e = hipLaunchCooperativeKernel((const void*)fwd_kernel, dim3(grid), dim3(512), args, LDS_BYTES, stream);
    if (e != hipSuccess) fprintf(stderr, "kernel_launch: cooperative launch failed: %s (grid %d)\n", hipGetErrorString(e), grid);
}
```

```cpp
#include <hip/hip_runtime.h>
#include <hip/hip_cooperative_groups.h>
#include <cstdio>
#include <cstdint>
namespace cg = cooperative_groups;
namespace pg8 {
#define PG8_LAS __attribute__((address_space(3)))
typedef unsigned short bf16_t;
typedef short bf16x8 __attribute__((ext_vector_type(8)));
typedef float f32x4 __attribute__((ext_vector_type(4)));
typedef unsigned u32x4 __attribute__((ext_vector_type(4)));
constexpr int BM = 256, BK = 64, HALF = 128, HTB = HALF * BK * 2  , STAGE_BYTES = 8 * HTB, NXCD = 8, WGM = 8;

__host__ __device__ __forceinline__ int lds_byte(int r, int c) { const int st = (r >> 4) * 2 + (c >> 5), rr = r & 15, cc = c & 31, ob = rr * 64 + cc * 2; return st * 1024 + (ob ^ (((ob >> 9) & 1) << 5)); }
__host__ __device__ __forceinline__ void stage_rc(int b, int& R, int& C) { const int st = b / 1024, sb = b % 1024, swz = sb ^ (((sb >> 9) & 1) << 5); R = (st >> 1) * 16 + swz / 64; C = (st & 1) * 32 + (swz % 64) / 2; }
__host__ __device__ __forceinline__ int perm32(int rho) { const int n = rho >> 4, i = rho & 15; return 8 * (i >> 2) + 4 * n + (i & 3); }

struct Unit { int pm, pn; };
struct Gemm { const bf16_t* A; const bf16_t* Bt; int M, N, K; };

struct StaticOrder {
    int nM, nN, nwg, G, c;
    __host__ __device__ void init(int M, int N, int G_, int c_) { nM = M / BM; nN = N / BM; nwg = nM * nN; G = G_; c = c_; }
    __host__ __device__ bool next(int i, Unit& u) const {
        const long L = (long)i * G + c; if (L >= nwg) return false;
        int wgid = (int)L; { const int q = nwg / NXCD, r = nwg % NXCD, xcd = wgid % NXCD, off = wgid / NXCD; wgid = (xcd < r ? xcd * (q + 1) : r * (q + 1) + (xcd - r) * q) + off; }
        const int nig = WGM * nN, gid = wgid / nig, fm = gid * WGM, gsz = (nM - fm) < WGM ? (nM - fm) : WGM;
        u.pm = fm + ((wgid % nig) % gsz); u.pn = (wgid % nig) / gsz; return true;
    }
    __device__ __forceinline__ void a_ready(const Unit&) const {}
    __device__ __forceinline__ void done(const Unit&) const {}
};

__device__ __forceinline__ unsigned cvt_pk_bf16(float lo, float hi) { unsigned r; asm volatile("v_cvt_pk_bf16_f32 %0, %1, %2" : "=v"(r) : "v"(lo), "v"(hi)); return r; }
struct EpiBf16 {
    static constexpr bool PERM = true, AFTER_DRAIN = false;
    bf16_t* O; int ldc;
    __device__ __forceinline__ void operator()(const f32x4 (&acc)[2][2][4][2], const Unit& u, int wr, int wc, int fr, int fq) const {
        const int row0 = u.pm * BM + wr * 64 + fr; const int col0 = u.pn * BM + wc * 32 + 8 * fq;
#pragma unroll
        for (int ai = 0; ai < 2; ++ai)
#pragma unroll
            for (int m = 0; m < 4; ++m) { bf16_t* rowp = O + (size_t)(row0 + ai * HALF + m * 16) * ldc + col0;
#pragma unroll
                for (int bj = 0; bj < 2; ++bj) { const f32x4 v0 = acc[ai][bj][m][0], v1 = acc[ai][bj][m][1];
                    u32x4 w; w.x = cvt_pk_bf16(v0[0], v0[1]); w.y = cvt_pk_bf16(v0[2], v0[3]); w.z = cvt_pk_bf16(v1[0], v1[1]); w.w = cvt_pk_bf16(v1[2], v1[3]);
                    *(u32x4*)(rowp + bj * HALF) = w; } }
    }
};
__device__ __forceinline__ float silu_f(float v) { return v / (1.0f + __expf(-v)); }
struct EpiSwiglu {
    static constexpr bool PERM = true, AFTER_DRAIN = false;
    bf16_t* O; int ldc;
    __device__ __forceinline__ void operator()(const f32x4 (&acc)[2][2][4][2], const Unit& u, int wr, int wc, int fr, int fq) const {
        const int row0 = u.pm * BM + wr * 64 + fr; const int col0 = u.pn * HALF + wc * 32 + 8 * fq;
#pragma unroll
        for (int ai = 0; ai < 2; ++ai)
#pragma unroll
            for (int m = 0; m < 4; ++m) { bf16_t* rowp = O + (size_t)(row0 + ai * HALF + m * 16) * ldc + col0;
                const f32x4 g0 = acc[ai][0][m][0], g1 = acc[ai][0][m][1], u0 = acc[ai][1][m][0], u1 = acc[ai][1][m][1];
                u32x4 w; w.x = cvt_pk_bf16(silu_f(g0[0]) * u0[0], silu_f(g0[1]) * u0[1]); w.y = cvt_pk_bf16(silu_f(g0[2]) * u0[2], silu_f(g0[3]) * u0[3]);
                w.z = cvt_pk_bf16(silu_f(g1[0]) * u1[0], silu_f(g1[1]) * u1[1]); w.w = cvt_pk_bf16(silu_f(g1[2]) * u1[2], silu_f(g1[3]) * u1[3]);
                *(u32x4*)rowp = w; }
    }
};

template <class Epi, class Sched, bool ALIGN_EPI = false, bool SP2 = false>
__device__ __forceinline__ void gemm_phase(PG8_LAS unsigned char* lds, const Gemm g, const Sched& S, const Epi& E) {
    const int tid = threadIdx.x, wid = __builtin_amdgcn_readfirstlane(tid >> 6), lane = tid & 63, wr = wid >> 2, wc = wid & 3, fr = lane & 15, fq = lane >> 4;
    const int K = g.K, nt = K / BK;
    unsigned voffA[2], voffB[2];
#pragma unroll
    for (int i = 0; i < 2; ++i) { int R, C; stage_rc(tid * 16 + i * 8192, R, C); const int Rb = Epi::PERM ? ((R & ~31) + perm32(R & 31)) : R;
        voffA[i] = (unsigned)(R * K + C) * 2u; voffB[i] = (unsigned)(Rb * K + C) * 2u; }
    const size_t kstep = (size_t)(BK * 2);
    const size_t hstep = (size_t)HALF * K * 2;
    const size_t tstep = 2 * hstep;
    const unsigned ldsw = (unsigned)wid * 1024u;
    const int aoff = lds_byte(wr * 64 + fr, fq * 8), boff = lds_byte(wc * 32 + fr, fq * 8);
#define PG8_SA(b, h) (((b) * 2 + (h)) * HTB)
#define PG8_SB(b, h) ((4 + (b) * 2 + (h)) * HTB)
#define PG8_STAGE(bufoff, gbase, voff) do { _Pragma("unroll") for (int _i = 0; _i < 2; ++_i) \
        __builtin_amdgcn_global_load_lds((const unsigned*)((const char*)(gbase) + (voff)[_i]), (PG8_LAS unsigned*)(lds + (bufoff) + ldsw + _i * 8192), 16, 0, 0); } while (0)
#define PG8_LDA(dst, b, h) do { _Pragma("unroll") for (int m = 0; m < 4; ++m) _Pragma("unroll") for (int k = 0; k < 2; ++k) dst[m][k] = *(const PG8_LAS bf16x8*)(lds + PG8_SA(b, h) + aoff + m * 2048 + k * 1024); } while (0)
#define PG8_LDB(dst, b, h) do { _Pragma("unroll") for (int n = 0; n < 2; ++n) _Pragma("unroll") for (int k = 0; k < 2; ++k) dst[n][k] = *(const PG8_LAS bf16x8*)(lds + PG8_SB(b, h) + boff + n * 2048 + k * 1024); } while (0)
#define PG8_MMA(ai, bj, At, Bt) do { __builtin_amdgcn_s_setprio(1); _Pragma("unroll") for (int m = 0; m < 4; ++m) _Pragma("unroll") for (int n = 0; n < 2; ++n) _Pragma("unroll") for (int k = 0; k < 2; ++k) \
        acc[ai][bj][m][n] = __builtin_amdgcn_mfma_f32_16x16x32_bf16(Bt[n][k], At[m][k], acc[ai][bj][m][n], 0, 0, 0); __builtin_amdgcn_s_setprio(0); } while (0)
#define PG8_WAIT_V(n) asm volatile("s_waitcnt vmcnt(" #n ")" ::: "memory")
#define PG8_WAIT_L(n) asm volatile("s_waitcnt lgkmcnt(" #n ")" ::: "memory")
#define PG8_BAR __builtin_amdgcn_s_barrier()
#define PG8_SCHED __builtin_amdgcn_sched_barrier(0)
    Unit cur, nxt; int ui = 0;
    if (!S.next(0, cur)) return;
    f32x4 acc[2][2][4][2];
#pragma unroll
    for (int a = 0; a < 2; ++a)
#pragma unroll
        for (int b = 0; b < 2; ++b)
#pragma unroll
            for (int m = 0; m < 4; ++m)
#pragma unroll
                for (int n = 0; n < 2; ++n) acc[a][b][m][n] = (f32x4){0.f, 0.f, 0.f, 0.f};
    bf16x8 At[4][2], B0[2][2], B1[2][2];
    const char* cA = (const char*)g.A + (size_t)cur.pm * tstep; const char* cB = (const char*)g.Bt + (size_t)cur.pn * tstep;
    S.a_ready(cur);
    if constexpr (SP2) {
        PG8_STAGE(PG8_SB(0, 0), cB, voffB); PG8_STAGE(PG8_SB(0, 1), cB + hstep, voffB); PG8_STAGE(PG8_SA(0, 0), cA, voffA); PG8_STAGE(PG8_SA(0, 1), cA + hstep, voffA);
        if (wr == 1) PG8_BAR;
        PG8_WAIT_V(2); PG8_BAR;
        PG8_STAGE(PG8_SB(1, 0), cB + kstep, voffB); PG8_STAGE(PG8_SA(1, 0), cA + kstep, voffA); PG8_STAGE(PG8_SB(1, 1), cB + hstep + kstep, voffB);
        PG8_WAIT_V(6); PG8_BAR;
    } else {
        PG8_STAGE(PG8_SB(0, 0), cB, voffB); PG8_STAGE(PG8_SA(0, 0), cA, voffA); PG8_STAGE(PG8_SB(0, 1), cB + hstep, voffB); PG8_STAGE(PG8_SA(0, 1), cA + hstep, voffA);
        if (wr == 1) PG8_BAR;
        PG8_WAIT_V(4); PG8_BAR;
        PG8_STAGE(PG8_SB(1, 0), cB + kstep, voffB); PG8_STAGE(PG8_SA(1, 0), cA + kstep, voffA); PG8_STAGE(PG8_SB(1, 1), cB + hstep + kstep, voffB);
        PG8_WAIT_V(6); PG8_BAR;
    }
    for (;;) {
        const bool has_next = S.next(ui + 1, nxt);
        const char* nA = has_next ? (const char*)g.A + (size_t)nxt.pm * tstep : cA; const char* nB = has_next ? (const char*)g.Bt + (size_t)nxt.pn * tstep : cB;
        for (int t = 0; t < nt; t += 2) {
            const bool last = (t == nt - 2);
            const char* a1 = cA + (size_t)(t + 1) * kstep;
            const char* a2 = last ? nA : cA + (size_t)(t + 2) * kstep; const char* b2 = last ? nB : cB + (size_t)(t + 2) * kstep;
            const char* a3 = a2 + kstep; const char* b3 = b2 + kstep;
            if (last && has_next) S.a_ready(nxt);
            if constexpr (SP2) {
            PG8_LDB(B0, 0, 0); PG8_LDB(B1, 0, 1); PG8_SCHED; PG8_LDA(At, 0, 0); PG8_STAGE(PG8_SA(1, 1), a1 + hstep, voffA);
            PG8_WAIT_V(8); PG8_WAIT_L(0); PG8_BAR; PG8_MMA(0, 0, At, B0); PG8_MMA(0, 1, At, B1); PG8_BAR; PG8_SCHED;
            PG8_LDA(At, 0, 1); PG8_STAGE(PG8_SB(0, 0), b2, voffB); PG8_STAGE(PG8_SB(0, 1), b2 + hstep, voffB); PG8_STAGE(PG8_SA(0, 0), a2, voffA);
            PG8_WAIT_V(8); PG8_WAIT_L(0); PG8_BAR; PG8_MMA(1, 0, At, B0); PG8_MMA(1, 1, At, B1); PG8_BAR; PG8_SCHED;
            PG8_LDB(B0, 1, 0); PG8_LDB(B1, 1, 1); PG8_SCHED; PG8_LDA(At, 1, 0); PG8_STAGE(PG8_SA(0, 1), a2 + hstep, voffA);
            PG8_WAIT_V(8); PG8_WAIT_L(0); PG8_BAR; PG8_MMA(0, 0, At, B0); PG8_MMA(0, 1, At, B1); PG8_BAR; PG8_SCHED;
            PG8_LDA(At, 1, 1); PG8_STAGE(PG8_SB(1, 0), b3, voffB); PG8_STAGE(PG8_SB(1, 1), b3 + hstep, voffB); PG8_STAGE(PG8_SA(1, 0), a3, voffA);
            PG8_WAIT_V(8); PG8_WAIT_L(0); PG8_BAR; PG8_MMA(1, 0, At, B0); PG8_MMA(1, 1, At, B1); PG8_BAR; PG8_SCHED;
            } else {
            PG8_LDB(B0, 0, 0); PG8_SCHED; PG8_LDA(At, 0, 0); PG8_STAGE(PG8_SA(1, 1), a1 + hstep, voffA);
            PG8_WAIT_L(8); PG8_BAR; PG8_WAIT_L(0); PG8_MMA(0, 0, At, B0); PG8_BAR; PG8_SCHED;
            PG8_LDB(B1, 0, 1); PG8_STAGE(PG8_SB(0, 0), b2, voffB);
            PG8_BAR; PG8_WAIT_L(0); PG8_MMA(0, 1, At, B1); PG8_BAR;
            PG8_LDA(At, 0, 1); PG8_STAGE(PG8_SA(0, 0), a2, voffA);
            PG8_BAR; PG8_WAIT_L(0); PG8_MMA(1, 0, At, B0); PG8_BAR; PG8_SCHED;
            PG8_STAGE(PG8_SB(0, 1), b2 + hstep, voffB);
            PG8_WAIT_V(6); PG8_BAR; PG8_MMA(1, 1, At, B1); PG8_BAR;
            PG8_LDB(B0, 1, 0); PG8_SCHED; PG8_LDA(At, 1, 0); PG8_STAGE(PG8_SA(0, 1), a2 + hstep, voffA);
            PG8_WAIT_L(8); PG8_BAR; PG8_WAIT_L(0); PG8_MMA(0, 0, At, B0); PG8_BAR; PG8_SCHED;
            PG8_LDB(B1, 1, 1); PG8_STAGE(PG8_SB(1, 0), b3, voffB);
            PG8_BAR; PG8_WAIT_L(0); PG8_MMA(0, 1, At, B1); PG8_BAR;
            PG8_LDA(At, 1, 1); PG8_STAGE(PG8_SA(1, 0), a3, voffA);
            PG8_BAR; PG8_WAIT_L(0); PG8_MMA(1, 0, At, B0); PG8_BAR; PG8_SCHED;
            PG8_STAGE(PG8_SB(1, 1), b3 + hstep, voffB);
            PG8_WAIT_V(6); PG8_BAR; PG8_MMA(1, 1, At, B1); PG8_BAR;
            }
        }
        if constexpr (ALIGN_EPI) { if (wr == 0) PG8_BAR; }
        if constexpr (!Epi::AFTER_DRAIN) { E(acc, cur, wr, wc, fr, fq); S.done(cur); }
        if (!has_next) break;
#pragma unroll
        for (int a = 0; a < 2; ++a)
#pragma unroll
            for (int b = 0; b < 2; ++b)
#pragma unroll
                for (int m = 0; m < 4; ++m)
#pragma unroll
                    for (int n = 0; n < 2; ++n) acc[a][b][m][n] = (f32x4){0.f, 0.f, 0.f, 0.f};
        cur = nxt; cA = nA; cB = nB; ++ui;
        if constexpr (ALIGN_EPI) { if (wr == 1) PG8_BAR; }
    }
    PG8_WAIT_V(0);
    if constexpr (!ALIGN_EPI) { if (wr == 0) PG8_BAR; }
    PG8_BAR;
    if constexpr (Epi::AFTER_DRAIN) { E.fused(acc, cur, wr, wc, fr, fq, lds, wid, lane); S.done(cur); }
#undef PG8_SA
#undef PG8_SB
#undef PG8_STAGE
#undef PG8_LDA
#undef PG8_LDB
#undef PG8_MMA
#undef PG8_WAIT_V
#undef PG8_WAIT_L
#undef PG8_BAR
#undef PG8_SCHED
}
}

constexpr int BATCH = 2, SEQ = 8192, M = BATCH * SEQ, D = 2048;
constexpr int NIN = 6672, NINP = 6912, DFF = 5632, NGU = 2 * DFF;
constexpr int C_Q = 0, C_F = 1024, C_I = 2048, C_G = 3072, C_Z = 4096, C_XBC = 5120, C_DT = 6656;
constexpr int XBC_W = 1536;
constexpr float EPS = 1e-6f;
constexpr size_t MiB = 1u << 20;
constexpr size_t WS_WIN = 1 * MiB;
constexpr size_t WS_WOUT = 28 * MiB;
constexpr size_t WS_WGU = 36 * MiB;
constexpr size_t WS_WDN = 80 * MiB;
constexpr size_t WS_XN = 102 * MiB;
constexpr size_t WS_PROJ = 166 * MiB;
constexpr size_t WS_ST = 382 * MiB;
constexpr size_t WS_DEC = 478 * MiB;
constexpr size_t WS_END = 480 * MiB;
constexpr int LDS_BYTES = 147456;

#define LAS __attribute__((address_space(3)))
typedef unsigned short bf16;
typedef float f32x4 __attribute__((ext_vector_type(4)));
typedef unsigned u32x4 __attribute__((ext_vector_type(4)));
#define LDS_WAIT() asm volatile("s_waitcnt lgkmcnt(0)" ::: "memory")
__device__ __forceinline__ float bf2f(unsigned short u) { return __uint_as_float(((unsigned)u) << 16); }
__device__ __forceinline__ unsigned f2bf(float f) { unsigned u = __float_as_uint(f); return (u + 0x7fffu + ((u >> 16) & 1u)) >> 16; }
__device__ __forceinline__ unsigned pk2(float lo, float hi) { return f2bf(lo) | (f2bf(hi) << 16); }
__device__ __forceinline__ float bflo(unsigned w) { return __uint_as_float(w << 16); }
__device__ __forceinline__ float bfhi(unsigned w) { return __uint_as_float(w & 0xffff0000u); }
__device__ __forceinline__ float wave_sum(float v) {
#pragma unroll
    for (int o = 1; o < 64; o <<= 1) v += __shfl_xor(v, o);
    return v;
}
__device__ __forceinline__ float sigm(float x) { return 1.0f / (1.0f + __expf(-x)); }
__device__ __forceinline__ float silu(float x) { return x / (1.0f + __expf(-x)); }

struct Params {
    const float *x, *pre_mix_w, *w_in, *lb_logits, *conv_w, *conv_b, *dt_bias, *a_log, *d_skip, *hgrn_nw, *ssd_nw, *w_out, *post_mix_w, *pre_ffn_w, *w_gate, *w_up, *w_down, *post_ffn_w;
    float* out; unsigned char* ws;
};

__device__ __forceinline__ void transpose_item(const float* W, int K, int N, bf16* WT, int k0, int n0, int rowb, LAS float* scr, int lane) {
    const int n_in = n0 + (lane & 31);
#pragma unroll 8
    for (int i = 0; i < 32; ++i) { const int kk = 2 * i + (lane >> 5); scr[kk * 33 + (lane & 31)] = (n_in < N) ? W[(size_t)(k0 + kk) * N + n_in] : 0.f; }
    LDS_WAIT();
    const int c = lane & 7;
#pragma unroll
    for (int j = 0; j < 4; ++j) { const int n = (lane >> 3) + 8 * j; const LAS float* s = scr + (8 * c) * 33 + n;
        u32x4 o; o.x = pk2(s[0 * 33], s[1 * 33]); o.y = pk2(s[2 * 33], s[3 * 33]); o.z = pk2(s[4 * 33], s[5 * 33]); o.w = pk2(s[6 * 33], s[7 * 33]);
        *(u32x4*)(WT + (size_t)(rowb + n) * K + k0 + 8 * c) = o; }
    LDS_WAIT();
}
__device__ __forceinline__ void rms_row_to_bf16(const float* xrow, const float* w, bf16* orow, int lane) {
    f32x4 v[8]; float ss = 0.f;
#pragma unroll
    for (int j = 0; j < 4; ++j) { const int base = 8 * (lane + 64 * j); v[2 * j] = *(const f32x4*)(xrow + base); v[2 * j + 1] = *(const f32x4*)(xrow + base + 4);
        const f32x4 a = v[2 * j], b = v[2 * j + 1]; ss += (a.x * a.x + a.y * a.y) + (a.z * a.z + a.w * a.w) + (b.x * b.x + b.y * b.y) + (b.z * b.z + b.w * b.w); }
    const float r = rsqrtf(wave_sum(ss) * (1.0f / D) + EPS);
#pragma unroll
    for (int j = 0; j < 4; ++j) { const int base = 8 * (lane + 64 * j); const f32x4 w0 = *(const f32x4*)(w + base), w1 = *(const f32x4*)(w + base + 4); const f32x4 a = v[2 * j], b = v[2 * j + 1];
        u32x4 o; o.x = pk2(a.x * r * w0.x, a.y * r * w0.y); o.y = pk2(a.z * r * w0.z, a.w * r * w0.w); o.z = pk2(b.x * r * w1.x, b.y * r * w1.y); o.w = pk2(b.z * r * w1.z, b.w * r * w1.w);
        *(u32x4*)(orow + base) = o; }
}

__device__ __forceinline__ void naive_hgrn(LAS unsigned char* lds, const Params& p, int bh) {
    const int tid = threadIdx.x, lane = tid & 63, wave = tid >> 6, quarter = tid >> 7, v = tid & 127;
    const int b = bh >> 3, h = bh & 7;
    const bf16* proj = (const bf16*)(p.ws + WS_PROJ); bf16* mixin = (bf16*)(p.ws + WS_XN);
    LAS float* fq = (LAS float*)lds; LAS float* qq = fq + 2048; LAS float* part = qq + 2048;
    float S[32];
#pragma unroll
    for (int i = 0; i < 32; ++i) S[i] = 0.f;
    for (int t0 = 0; t0 < SEQ; t0 += 16) {
        const size_t rowb = (size_t)b * SEQ + t0;
        for (int e = tid; e < 2048; e += 512) { const int tt = e >> 7, k = e & 127; const bf16* pr = proj + (rowb + tt) * NINP + h * 128 + k;
            const float qr = bf2f(pr[C_Q]), fr = bf2f(pr[C_F]); const float l0 = p.lb_logits[h * 128 + k], l1 = p.lb_logits[1024 + h * 128 + k]; const float lb = 1.0f / (1.0f + expf(l1 - l0));
            fq[e] = lb + (1.0f - lb) * sigm(fr); qq[e] = silu(qr) * 0.08838834764831845f; }
        __syncthreads();
        for (int tt = 0; tt < 16; ++tt) { const float iv = bf2f(proj[(rowb + tt) * NINP + C_I + h * 128 + v]); float acc = 0.f;
#pragma unroll
            for (int kk = 0; kk < 32; ++kk) { const float f = fq[tt * 128 + quarter * 32 + kk]; S[kk] = f * S[kk] + (1.0f - f) * iv; acc += S[kk] * qq[tt * 128 + quarter * 32 + kk]; }
            part[(quarter * 16 + tt) * 128 + v] = acc; }
        __syncthreads();
        for (int tt = 2 * wave; tt < 2 * wave + 2; ++tt) {
            float o0 = 0.f, o1 = 0.f;
#pragma unroll
            for (int q = 0; q < 4; ++q) { o0 += part[(q * 16 + tt) * 128 + lane]; o1 += part[(q * 16 + tt) * 128 + 64 + lane]; }
            const float r = rsqrtf(wave_sum(o0 * o0 + o1 * o1) * (1.0f / 128.0f) + EPS);
            const bf16* pr = proj + (rowb + tt) * NINP + C_G + h * 128; const float g0 = bf2f(pr[lane]), g1 = bf2f(pr[64 + lane]);
            bf16* mo = mixin + (rowb + tt) * 2048 + h * 128;
            mo[lane] = (bf16)f2bf(o0 * r * p.hgrn_nw[h * 128 + lane] * silu(g0)); mo[64 + lane] = (bf16)f2bf(o1 * r * p.hgrn_nw[h * 128 + 64 + lane] * silu(g1));
        }
        __syncthreads();
    }
}
__device__ __forceinline__ void naive_ssd(LAS unsigned char* lds, const Params& p, int bg) {
    const int tid = threadIdx.x, lane = tid & 63, wave = tid >> 6;
    const int b = bg >> 1, g = bg & 1, hh = wave, head = g * 8 + hh, pp = lane;
    const bf16* proj = (const bf16*)(p.ws + WS_PROJ); bf16* mixin = (bf16*)(p.ws + WS_XN);
    LAS float* Bs = (LAS float*)lds; LAS float* Cs = Bs + 2048; LAS float* xs = Cs + 2048; LAS float* yb = xs + 8192; LAS float* dtl = yb + 8192;
    float hst[128];
#pragma unroll
    for (int i = 0; i < 128; ++i) hst[i] = 0.f;
    const float A = -expf(p.a_log[head]), Dk = p.d_skip[head];
    for (int t0 = 0; t0 < SEQ; t0 += 16) {
        const size_t rowb = (size_t)b * SEQ + t0;
        for (int e = tid; e < 16 * 768; e += 512) { const int tt = e / 768, ch = e - tt * 768;
            const int col = ch < 512 ? g * 512 + ch : (ch < 640 ? 1024 + g * 128 + (ch - 512) : 1280 + g * 128 + (ch - 640));
            float acc = p.conv_b[col];
#pragma unroll
            for (int kk = 0; kk < 4; ++kk) { const int ts = t0 + tt - 3 + kk; if (ts >= 0) acc += p.conv_w[kk * XBC_W + col] * bf2f(proj[((size_t)b * SEQ + ts) * NINP + C_XBC + col]); }
            const float val = silu(acc);
            if (ch < 512) xs[tt * 512 + ch] = val; else if (ch < 640) Bs[tt * 128 + ch - 512] = val; else Cs[tt * 128 + ch - 640] = val; }
        if (tid < 128) { const int tt = tid >> 3, h8 = tid & 7; const float xr = bf2f(proj[(rowb + tt) * NINP + C_DT + g * 8 + h8]) + p.dt_bias[g * 8 + h8]; dtl[tid] = xr > 20.f ? xr : log1pf(expf(xr)); }
        __syncthreads();
        for (int tt = 0; tt < 16; ++tt) { const float dt = dtl[tt * 8 + hh], dA = expf(dt * A), xv = xs[tt * 512 + hh * 64 + pp], xdt = xv * dt; float y = 0.f;
#pragma unroll
            for (int n = 0; n < 128; ++n) { hst[n] = dA * hst[n] + xdt * Bs[tt * 128 + n]; y += Cs[tt * 128 + n] * hst[n]; }
            y += Dk * xv; const float z = bf2f(proj[(rowb + tt) * NINP + C_Z + head * 64 + pp]); yb[tt * 512 + hh * 64 + pp] = y * silu(z); }
        __syncthreads();
        for (int tt = 2 * wave; tt < 2 * wave + 2; ++tt) {
            float yv[8]; float ss = 0.f;
#pragma unroll
            for (int j = 0; j < 8; ++j) { yv[j] = yb[tt * 512 + lane + 64 * j]; ss += yv[j] * yv[j]; }
            const float r = rsqrtf(wave_sum(ss) * (1.0f / 512.0f) + EPS);
            bf16* mo = mixin + (rowb + tt) * 2048 + 1024 + g * 512;
#pragma unroll
            for (int j = 0; j < 8; ++j) mo[lane + 64 * j] = (bf16)f2bf(yv[j] * r * p.ssd_nw[g * 512 + lane + 64 * j]);
        }
        __syncthreads();
    }
}

constexpr size_t WS_ST_S = WS_ST + 64 * MiB;
constexpr size_t WS_DEC_S = WS_DEC + 1 * MiB;
typedef short bf16x8 __attribute__((ext_vector_type(8)));
typedef unsigned u32x2 __attribute__((ext_vector_type(2)));
__device__ __forceinline__ f32x4 mma_lds(const LAS bf16* A, int lda, const LAS bf16* Bt, int ldb, int K, f32x4 acc, int lane) {
    const int r = lane & 15, q = lane >> 4;
    for (int k0 = 0; k0 < K; k0 += 32) {
        const bf16x8 a = *(const LAS bf16x8*)(A + r * lda + k0 + 8 * q);
        const bf16x8 b = *(const LAS bf16x8*)(Bt + r * ldb + k0 + 8 * q);
        acc = __builtin_amdgcn_mfma_f32_16x16x32_bf16(a, b, acc, 0, 0, 0);
    }
    return acc;
}
__device__ __forceinline__ f32x4 mma_lds_glb(const LAS bf16* A, int lda, const bf16* Bt, int ldb, int K, f32x4 acc, int lane) {
    const int r = lane & 15, q = lane >> 4;
    for (int k0 = 0; k0 < K; k0 += 32) {
        const bf16x8 a = *(const LAS bf16x8*)(A + r * lda + k0 + 8 * q);
        const bf16x8 b = *(const bf16x8*)(Bt + (size_t)r * ldb + k0 + 8 * q);
        acc = __builtin_amdgcn_mfma_f32_16x16x32_bf16(a, b, acc, 0, 0, 0);
    }
    return acc;
}
__device__ __forceinline__ float softplus(float x) { return x > 20.f ? x : log1pf(expf(x)); }

template <bool OUT>
__device__ __forceinline__ void hgrn_unit(LAS unsigned char* lds, const Params& p, int u) {
    const int tid = threadIdx.x, lane = tid & 63, wave = tid >> 6, I = tid >> 7, k = tid & 127, r = lane & 15, q = lane >> 4;
    const int b = u >> 10, c = (u >> 3) & 127, h = u & 7;
    const size_t row0 = (size_t)b * SEQ + c * 64;
    const bf16* proj = (const bf16*)(p.ws + WS_PROJ);
    const int uh = (b * 8 + h) * 128 + c;
    bf16* ST = (bf16*)(p.ws + WS_ST) + (size_t)uh * 16384;
    LAS float* Tsum = (LAS float*)lds;
    LAS bf16* vT = (LAS bf16*)(lds + 2048);
    LAS bf16* KdT = (LAS bf16*)(lds + 20480);
    LAS bf16* Qt = (LAS bf16*)(lds + 20480);
    LAS bf16* Qb = Qt + 64 * 136;
    LAS bf16* KT = Qb + 64 * 136;
    LAS bf16* P = KT + 160 * 136;
    LAS float* red = (LAS float*)(P + 64 * 72);
    const float l0 = p.lb_logits[h * 128 + k], l1 = p.lb_logits[1024 + h * 128 + k]; const float lb = 1.0f / (1.0f + expf(l1 - l0));
    float bl[16], kk[16], qv[16];
    {
        const bf16* pr = proj + (row0 + 16 * I) * NINP + h * 128 + k; float run = 0.f;
#pragma unroll
        for (int j = 0; j < 16; ++j) { const float fr = bf2f(pr[(size_t)j * NINP + C_F]); const float fg = lb + (1.0f - lb) * sigm(fr); run += logf(fg); bl[j] = run; kk[j] = 1.0f - fg;
            if (OUT) { const float qr = bf2f(pr[(size_t)j * NINP + C_Q]); qv[j] = silu(qr) * 0.08838834764831845f; } else qv[j] = 0.f; }
        Tsum[I * 128 + k] = run;
        const bf16* pv = pr + C_I; unsigned w[8];
#pragma unroll
        for (int j2 = 0; j2 < 8; ++j2) w[j2] = (unsigned)pv[(size_t)(2 * j2) * NINP] | ((unsigned)pv[(size_t)(2 * j2 + 1) * NINP] << 16);
        LAS u32x4* dst = (LAS u32x4*)(vT + k * 72 + 16 * I); dst[0] = (u32x4){w[0], w[1], w[2], w[3]}; dst[1] = (u32x4){w[4], w[5], w[6], w[7]};
    }
    __syncthreads();
    const float T0 = Tsum[k], T1 = Tsum[128 + k], T2 = Tsum[256 + k], T3 = Tsum[384 + k];
    const float start = (I > 0 ? T0 : 0.f) + (I > 1 ? T1 : 0.f) + (I > 2 ? T2 : 0.f), btot = (T0 + T1) + (T2 + T3);
    if (!OUT) {
        unsigned w[8]; const float e0 = btot - start;
#pragma unroll
        for (int j2 = 0; j2 < 8; ++j2) w[j2] = pk2(kk[2 * j2] * __expf(e0 - bl[2 * j2]), kk[2 * j2 + 1] * __expf(e0 - bl[2 * j2 + 1]));
        LAS u32x4* dst = (LAS u32x4*)(KdT + k * 72 + 16 * I); dst[0] = (u32x4){w[0], w[1], w[2], w[3]}; dst[1] = (u32x4){w[4], w[5], w[6], w[7]};
        if (I == 0) ((float*)(p.ws + WS_DEC))[(size_t)uh * 128 + k] = __expf(btot);
        __syncthreads();
#pragma unroll
        for (int n = 0; n < 8; ++n) {
            const f32x4 acc = mma_lds(KdT + 16 * wave * 72, 72, vT + 16 * n * 72, 72, 64, (f32x4){0.f, 0.f, 0.f, 0.f}, lane);
            *(u32x2*)(ST + (16 * n + r) * 128 + 16 * wave + 4 * q) = (u32x2){pk2(acc[0], acc[1]), pk2(acc[2], acc[3])};
        }
        __syncthreads();
        return;
    }
    {
        const float es = __expf(start);
#pragma unroll
        for (int j = 0; j < 16; ++j) { const int t = 16 * I + j; const float e1 = qv[j] * __expf(bl[j]); Qt[t * 136 + k] = (bf16)f2bf(e1); Qb[t * 136 + k] = (bf16)f2bf(e1 * es); }
        float Dacc = 0.f;
#pragma unroll
        for (int I2 = 0; I2 < 4; ++I2) {
            if (I2 >= I) { const int pair = I2 * (I2 + 1) / 2 + I;
#pragma unroll
                for (int j = 0; j < 16; ++j) KT[(pair * 16 + j) * 136 + k] = (bf16)f2bf(kk[j] * __expf(Dacc - bl[j]));
                Dacc += (I2 == 0 ? T0 : I2 == 1 ? T1 : I2 == 2 ? T2 : T3); }
        }
    }
    __syncthreads();
    {
        const int I2 = wave >> 1;
#pragma unroll
        for (int jj = 0; jj < 2; ++jj) { const int J = 2 * (wave & 1) + jj; f32x4 sc = (f32x4){0.f, 0.f, 0.f, 0.f};
            if (J <= I2) { const int pair = I2 * (I2 + 1) / 2 + J; sc = mma_lds(Qt + 16 * I2 * 136, 136, KT + pair * 16 * 136, 136, 128, sc, lane);
                if (J == I2) {
#pragma unroll
                    for (int j = 0; j < 4; ++j) if (r > 4 * q + j) sc[j] = 0.f; } }
#pragma unroll
            for (int j = 0; j < 4; ++j) P[(16 * I2 + 4 * q + j) * 72 + 16 * J + r] = (bf16)f2bf(sc[j]); }
    }
    __syncthreads();
    {
        const int rt = wave >> 1; f32x4 o[4]; float ssq[4] = {0.f, 0.f, 0.f, 0.f};
#pragma unroll
        for (int c4 = 0; c4 < 4; ++c4) { const int n = 4 * (wave & 1) + c4;
            f32x4 acc = mma_lds(P + 16 * rt * 72, 72, vT + 16 * n * 72, 72, 64, (f32x4){0.f, 0.f, 0.f, 0.f}, lane);
            acc = mma_lds_glb(Qb + 16 * rt * 136, 136, ST + (size_t)(16 * n) * 128, 128, 128, acc, lane);
            o[c4] = acc;
#pragma unroll
            for (int j = 0; j < 4; ++j) ssq[j] += acc[j] * acc[j]; }
#pragma unroll
        for (int j = 0; j < 4; ++j) { float s = ssq[j]; s += __shfl_xor(s, 1); s += __shfl_xor(s, 2); s += __shfl_xor(s, 4); s += __shfl_xor(s, 8); if (r == 0) red[(16 * rt + 4 * q + j) * 2 + (wave & 1)] = s; }
        __syncthreads();
        bf16* mixin = (bf16*)(p.ws + WS_XN);
#pragma unroll
        for (int j = 0; j < 4; ++j) { const int t = 16 * rt + 4 * q + j; const float rs = rsqrtf((red[t * 2] + red[t * 2 + 1]) * (1.0f / 128.0f) + EPS);
#pragma unroll
            for (int c4 = 0; c4 < 4; ++c4) { const int v = 16 * (4 * (wave & 1) + c4) + r; const float gg = bf2f(proj[(row0 + t) * NINP + C_G + h * 128 + v]);
                mixin[(row0 + t) * 2048 + h * 128 + v] = (bf16)f2bf(o[c4][j] * rs * p.hgrn_nw[h * 128 + v] * silu(gg)); } }
    }
    __syncthreads();
}

template <bool OUT>
__device__ __forceinline__ void ssd_unit(LAS unsigned char* lds, const Params& p, int u) {
    const int tid = threadIdx.x, lane = tid & 63, wave = tid >> 6, r = lane & 15, q = lane >> 4;
    const int b = u >> 7, c = (u >> 1) & 63, g = u & 1;
    const size_t row0 = (size_t)b * SEQ + c * 128;
    const bf16* proj = (const bf16*)(p.ws + WS_PROJ); bf16* mixin = (bf16*)(p.ws + WS_XN);
    LAS float* acs = (LAS float*)lds;
    LAS float* dtl = acs + 1024;
    LAS bf16* Cn = (LAS bf16*)(lds + 8192);
    LAS bf16* Bn = Cn + 128 * 136;
    LAS bf16* xT = Bn + 128 * 136;
    LAS bf16* xsN = xT + 64 * 136;
    LAS float* red = (LAS float*)(xsN + 128 * 72);
    {
        const int head = g * 8 + wave; const float A = -expf(p.a_log[head]), db = p.dt_bias[head];
        const float d0 = softplus(bf2f(proj[(row0 + lane) * NINP + C_DT + head]) + db), d1 = softplus(bf2f(proj[(row0 + 64 + lane) * NINP + C_DT + head]) + db);
        float a0 = d0 * A, a1 = d1 * A;
#pragma unroll
        for (int o = 1; o < 64; o <<= 1) { const float t0 = __shfl_up(a0, o), t1 = __shfl_up(a1, o); if (lane >= o) { a0 += t0; a1 += t1; } }
        a1 += __shfl(a0, 63);
        acs[wave * 128 + lane] = a0; acs[wave * 128 + 64 + lane] = a1; dtl[wave * 128 + lane] = d0; dtl[wave * 128 + 64 + lane] = d1;
        if (!OUT && lane == 63) ((float*)(p.ws + WS_DEC_S))[(b * 16 + head) * 64 + c] = __expf(a1);
    }
    {
        const int ch = tid & 127, which = (tid >> 7) & 1, seg = tid >> 8;
        if (OUT || which == 0) {
            const int col = 1024 + which * 256 + g * 128 + ch, tb = 64 * seg;
            const bf16* pc = proj + row0 * NINP + C_XBC + col;
            const float w0 = p.conv_w[col], w1 = p.conv_w[XBC_W + col], w2 = p.conv_w[2 * XBC_W + col], w3 = p.conv_w[3 * XBC_W + col], bias = p.conv_b[col];
            const bool hal = (c * 128 + tb) > 0;
            float r0 = hal ? bf2f(pc[(long)(tb - 3) * NINP]) : 0.f, r1 = hal ? bf2f(pc[(long)(tb - 2) * NINP]) : 0.f, r2 = hal ? bf2f(pc[(long)(tb - 1) * NINP]) : 0.f;
            LAS bf16* dstn = (which == 0 ? Bn : Cn);
            const bf16* pcc = pc + (long)tb * NINP;
#pragma unroll 4
            for (int i = 0; i < 64; ++i, pcc += NINP) { const float r3 = bf2f(*pcc); const float val = silu(bias + w0 * r0 + w1 * r1 + w2 * r2 + w3 * r3); r0 = r1; r1 = r2; r2 = r3;
                if (OUT) dstn[(tb + i) * 136 + ch] = (bf16)f2bf(val); else Cn[ch * 136 + tb + i] = (bf16)f2bf(val); }
        }
    }
    __syncthreads();
    f32x4 cb[8];
    if (OUT) {
#pragma unroll
        for (int n8 = 0; n8 < 8; ++n8) cb[n8] = mma_lds(Cn + 16 * wave * 136, 136, Bn + 16 * n8 * 136, 136, 128, (f32x4){0.f, 0.f, 0.f, 0.f}, lane);
        __syncthreads();
    }
    float ssq[4] = {0.f, 0.f, 0.f, 0.f};
    for (int hh = 0; hh < 8; ++hh) {
        const int head = g * 8 + hh;
        {
            const int pp = tid & 63, seg = tid >> 6, col = g * 512 + hh * 64 + pp, tb = 16 * seg;
            const bf16* pc = proj + row0 * NINP + C_XBC + col;
            const float w0 = p.conv_w[col], w1 = p.conv_w[XBC_W + col], w2 = p.conv_w[2 * XBC_W + col], w3 = p.conv_w[3 * XBC_W + col], bias = p.conv_b[col];
            const bool hal = (c * 128 + tb) > 0;
            float r0 = hal ? bf2f(pc[(long)(tb - 3) * NINP]) : 0.f, r1 = hal ? bf2f(pc[(long)(tb - 2) * NINP]) : 0.f, r2 = hal ? bf2f(pc[(long)(tb - 1) * NINP]) : 0.f;
            const float alast = acs[hh * 128 + 127];
            unsigned w[8]; float prev = 0.f;
            const bf16* pcc = pc + (long)tb * NINP;
#pragma unroll
            for (int i = 0; i < 16; ++i, pcc += NINP) { const float r3 = bf2f(*pcc); const float val = silu(bias + w0 * r0 + w1 * r1 + w2 * r2 + w3 * r3); r0 = r1; r1 = r2; r2 = r3;
                const int s = tb + i; float xv = val * dtl[hh * 128 + s];
                if (OUT) xsN[s * 72 + pp] = (bf16)f2bf(val); else xv *= __expf(alast - acs[hh * 128 + s]);
                if (i & 1) w[i >> 1] = pk2(prev, xv); else prev = xv; }
            LAS u32x4* dst = (LAS u32x4*)(xT + pp * 136 + tb); dst[0] = (u32x4){w[0], w[1], w[2], w[3]}; dst[1] = (u32x4){w[4], w[5], w[6], w[7]};
        }
        if (OUT) {
            LAS bf16* W = Bn;
#pragma unroll
            for (int n8 = 0; n8 < 8; ++n8)
#pragma unroll
                for (int j = 0; j < 4; ++j) { const int t = 16 * wave + 4 * q + j, s = 16 * n8 + r;
                    const float val = (s <= t) ? cb[n8][j] * __expf(acs[hh * 128 + t] - acs[hh * 128 + s]) : 0.f; W[t * 136 + s] = (bf16)f2bf(val); }
        }
        __syncthreads();
        if (OUT) {
            const bf16* prevS = (const bf16*)(p.ws + WS_ST_S) + (size_t)((b * 16 + head) * 64 + c) * 8192; const float Dk = p.d_skip[head];
#pragma unroll 1
            for (int c4 = 0; c4 < 4; ++c4) {
                const f32x4 accd = mma_lds(Bn + 16 * wave * 136, 136, xT + 16 * c4 * 136, 136, 128, (f32x4){0.f, 0.f, 0.f, 0.f}, lane);
                const f32x4 acco = mma_lds_glb(Cn + 16 * wave * 136, 136, prevS + (size_t)(16 * c4) * 128, 128, 128, (f32x4){0.f, 0.f, 0.f, 0.f}, lane);
#pragma unroll
                for (int j = 0; j < 4; ++j) { const int t = 16 * wave + 4 * q + j, pcol = 16 * c4 + r;
                    float y = accd[j] + __expf(acs[hh * 128 + t]) * acco[j] + Dk * bf2f(xsN[t * 72 + pcol]);
                    const float z = bf2f(proj[(row0 + t) * NINP + C_Z + head * 64 + pcol]); y *= silu(z); ssq[j] += y * y;
                    mixin[(row0 + t) * 2048 + 1024 + g * 512 + hh * 64 + pcol] = (bf16)f2bf(y * p.ssd_nw[g * 512 + hh * 64 + pcol]); }
            }
        } else {
            bf16* Lst = (bf16*)(p.ws + WS_ST_S) + (size_t)((b * 16 + head) * 64 + c) * 8192;
#pragma unroll
            for (int c4 = 0; c4 < 4; ++c4) {
                const f32x4 acc = mma_lds(Cn + 16 * wave * 136, 136, xT + 16 * c4 * 136, 136, 128, (f32x4){0.f, 0.f, 0.f, 0.f}, lane);
                *(u32x2*)(Lst + (16 * c4 + r) * 128 + 16 * wave + 4 * q) = (u32x2){pk2(acc[0], acc[1]), pk2(acc[2], acc[3])};
            }
        }
        __syncthreads();
    }
    if (OUT) {
#pragma unroll
        for (int j = 0; j < 4; ++j) { float s = ssq[j]; s += __shfl_xor(s, 1); s += __shfl_xor(s, 2); s += __shfl_xor(s, 4); s += __shfl_xor(s, 8); if (r == 0) red[16 * wave + 4 * q + j] = rsqrtf(s * (1.0f / 512.0f) + EPS); }
        __syncthreads();
        for (int e = tid; e < 128 * 64; e += 512) { const int t = e >> 6, c8 = e & 63; const float rs = red[t];
            u32x4* ptr = (u32x4*)(mixin + (row0 + t) * 2048 + 1024 + g * 512 + 8 * c8); u32x4 w = *ptr;
            w.x = pk2(bflo(w.x) * rs, bfhi(w.x) * rs); w.y = pk2(bflo(w.y) * rs, bfhi(w.y) * rs); w.z = pk2(bflo(w.z) * rs, bfhi(w.z) * rs); w.w = pk2(bflo(w.w) * rs, bfhi(w.w) * rs); *ptr = w; }
        __syncthreads();
    }
}

__device__ __forceinline__ void state_scan(const Params& p, int gt, int GT) {
    for (int e = gt; e < 131072; e += GT) {
        if (e < 65536) {
            const int bh = e >> 12, off4 = e & 4095;
            bf16* st = (bf16*)(p.ws + WS_ST) + (size_t)bh * 128 * 16384 + off4 * 4; const float* dec = (const float*)(p.ws + WS_DEC) + (size_t)bh * 128 * 128 + (off4 & 31) * 4;
            f32x4 S = (f32x4){0.f, 0.f, 0.f, 0.f};
            for (int c0 = 0; c0 < 128; c0 += 8) {
                u32x2 L[8]; f32x4 d[8];
#pragma unroll
                for (int i = 0; i < 8; ++i) { L[i] = *(const u32x2*)(st + (size_t)(c0 + i) * 16384); d[i] = *(const f32x4*)(dec + (c0 + i) * 128); }
#pragma unroll
                for (int i = 0; i < 8; ++i) { *(u32x2*)(st + (size_t)(c0 + i) * 16384) = (u32x2){pk2(S.x, S.y), pk2(S.z, S.w)};
                    S.x = d[i].x * S.x + bflo(L[i].x); S.y = d[i].y * S.y + bfhi(L[i].x); S.z = d[i].z * S.z + bflo(L[i].y); S.w = d[i].w * S.w + bfhi(L[i].y); }
            }
        } else {
            const int e2 = e - 65536, bhd = e2 >> 11, off4 = e2 & 2047;
            bf16* st = (bf16*)(p.ws + WS_ST_S) + (size_t)bhd * 64 * 8192 + off4 * 4; const float* dec = (const float*)(p.ws + WS_DEC_S) + bhd * 64;
            f32x4 S = (f32x4){0.f, 0.f, 0.f, 0.f};
            for (int c0 = 0; c0 < 64; c0 += 8) {
                u32x2 L[8]; float d[8];
#pragma unroll
                for (int i = 0; i < 8; ++i) { L[i] = *(const u32x2*)(st + (size_t)(c0 + i) * 8192); d[i] = dec[c0 + i]; }
#pragma unroll
                for (int i = 0; i < 8; ++i) { *(u32x2*)(st + (size_t)(c0 + i) * 8192) = (u32x2){pk2(S.x, S.y), pk2(S.z, S.w)};
                    S.x = d[i] * S.x + bflo(L[i].x); S.y = d[i] * S.y + bfhi(L[i].x); S.z = d[i] * S.z + bflo(L[i].y); S.w = d[i] * S.w + bfhi(L[i].y); }
            }
        }
    }
}

#ifndef MIX_MODE
#define MIX_MODE 1
#endif
__global__ void __launch_bounds__(512) fwd_kernel(Params p) {
    extern __shared__ __attribute__((aligned(16))) unsigned char lds_raw[];
    LAS unsigned char* lds = (LAS unsigned char*)lds_raw;
    cg::grid_group grid = cg::this_grid();
    const int tid = threadIdx.x, lane = tid & 63, wave = __builtin_amdgcn_readfirstlane(tid >> 6);
    const int G = gridDim.x, gw = blockIdx.x * 8 + wave, NGW = G * 8;
    bf16* WIN = (bf16*)(p.ws + WS_WIN); bf16* WOUT = (bf16*)(p.ws + WS_WOUT); bf16* WGU = (bf16*)(p.ws + WS_WGU); bf16* WDN = (bf16*)(p.ws + WS_WDN);
    bf16* XN = (bf16*)(p.ws + WS_XN); bf16* PROJ = (bf16*)(p.ws + WS_PROJ); bf16* HID = (bf16*)(p.ws + WS_PROJ); bf16* MIXO = (bf16*)(p.ws + WS_ST); bf16* FF = (bf16*)(p.ws + WS_ST);

    {
        LAS float* scr = (LAS float*)(lds + wave * 16384);
        constexpr int I_IN = 32 * (NINP / 32), I_OUT = 32 * (D / 32), I_G = 32 * (DFF / 32), I_DN = (DFF / 64) * (D / 32);
        constexpr int NITEMS = I_IN + I_OUT + 2 * I_G + I_DN;
        for (int it = gw; it < NITEMS; it += NGW) {
            int r = it;
            if (r < I_IN) { const int nb = NINP / 32, kb = r / nb, n0 = 32 * (r % nb); transpose_item(p.w_in, D, NIN, WIN, 64 * kb, n0, n0, scr, lane); continue; } r -= I_IN;
            if (r < I_OUT) { const int nb = D / 32, kb = r / nb, n0 = 32 * (r % nb); transpose_item(p.w_out, D, D, WOUT, 64 * kb, n0, n0, scr, lane); continue; } r -= I_OUT;
            if (r < I_G) { const int nb = DFF / 32, kb = r / nb, n0 = 32 * (r % nb); transpose_item(p.w_gate, D, DFF, WGU, 64 * kb, n0, 256 * (n0 >> 7) + (n0 & 127), scr, lane); continue; } r -= I_G;
            if (r < I_G) { const int nb = DFF / 32, kb = r / nb, n0 = 32 * (r % nb); transpose_item(p.w_up, D, DFF, WGU, 64 * kb, n0, 256 * (n0 >> 7) + 128 + (n0 & 127), scr, lane); continue; } r -= I_G;
            { const int nb = D / 32, kb = r / nb, n0 = 32 * (r % nb); transpose_item(p.w_down, DFF, D, WDN, 64 * kb, n0, n0, scr, lane); }
        }
        for (int m = gw; m < M; m += NGW) rms_row_to_bf16(p.x + (size_t)m * D, p.pre_mix_w, XN + (size_t)m * D, lane);
    }
    grid.sync();
    {
        pg8::Gemm g{XN, WIN, M, NINP, D}; pg8::StaticOrder S; S.init(M, NINP, G, (int)blockIdx.x); pg8::EpiBf16 E{PROJ, NINP};
        pg8::gemm_phase<pg8::EpiBf16, pg8::StaticOrder, true, true>(lds, g, S, E);
    }
    grid.sync();
    if (MIX_MODE != 0) {
        if (MIX_MODE != 3) for (int u = blockIdx.x; u < 256; u += G) ssd_unit<false>(lds, p, u);
        if (MIX_MODE != 2) for (int u = blockIdx.x; u < 2048; u += G) hgrn_unit<false>(lds, p, u);
        grid.sync();
        state_scan(p, (int)blockIdx.x * 512 + tid, G * 512);
        grid.sync();
        if (MIX_MODE != 3) for (int u = blockIdx.x; u < 256; u += G) ssd_unit<true>(lds, p, u);
        if (MIX_MODE != 2) for (int u = blockIdx.x; u < 2048; u += G) hgrn_unit<true>(lds, p, u);
    }
    if (MIX_MODE == 0 || MIX_MODE == 3) { if (blockIdx.x < 16) naive_hgrn(lds, p, (int)blockIdx.x); }
    if (MIX_MODE == 0 || MIX_MODE == 2) { if (blockIdx.x >= 16 && blockIdx.x < 20) naive_ssd(lds, p, (int)blockIdx.x - 16); }
    grid.sync();
    {
        pg8::Gemm g{XN, WOUT, M, D, D}; pg8::StaticOrder S; S.init(M, D, G, (int)blockIdx.x); pg8::EpiBf16 E{MIXO, D};
        pg8::gemm_phase<pg8::EpiBf16, pg8::StaticOrder, true, true>(lds, g, S, E);
    }
    grid.sync();
    for (int m = gw; m < M; m += NGW) {
        const float* xr = p.x + (size_t)m * D; const bf16* mr = MIXO + (size_t)m * D; float* orow = p.out + (size_t)m * D; bf16* xn = XN + (size_t)m * D;
        u32x4 mw[4]; float ss = 0.f;
#pragma unroll
        for (int j = 0; j < 4; ++j) { mw[j] = *(const u32x4*)(mr + 8 * (lane + 64 * j));
            const float a0 = bflo(mw[j].x), a1 = bfhi(mw[j].x), a2 = bflo(mw[j].y), a3 = bfhi(mw[j].y), a4 = bflo(mw[j].z), a5 = bfhi(mw[j].z), a6 = bflo(mw[j].w), a7 = bfhi(mw[j].w);
            ss += (a0 * a0 + a1 * a1) + (a2 * a2 + a3 * a3) + (a4 * a4 + a5 * a5) + (a6 * a6 + a7 * a7); }
        const float r1 = rsqrtf(wave_sum(ss) * (1.0f / D) + EPS);
        f32x4 x1[8]; float ss1 = 0.f;
#pragma unroll
        for (int j = 0; j < 4; ++j) { const int base = 8 * (lane + 64 * j);
            const f32x4 xa = *(const f32x4*)(xr + base), xb = *(const f32x4*)(xr + base + 4), wa = *(const f32x4*)(p.post_mix_w + base), wb = *(const f32x4*)(p.post_mix_w + base + 4);
            f32x4 a, b2;
            a.x = xa.x + bflo(mw[j].x) * r1 * wa.x; a.y = xa.y + bfhi(mw[j].x) * r1 * wa.y; a.z = xa.z + bflo(mw[j].y) * r1 * wa.z; a.w = xa.w + bfhi(mw[j].y) * r1 * wa.w;
            b2.x = xb.x + bflo(mw[j].z) * r1 * wb.x; b2.y = xb.y + bfhi(mw[j].z) * r1 * wb.y; b2.z = xb.z + bflo(mw[j].w) * r1 * wb.z; b2.w = xb.w + bfhi(mw[j].w) * r1 * wb.w;
            x1[2 * j] = a; x1[2 * j + 1] = b2; *(f32x4*)(orow + base) = a; *(f32x4*)(orow + base + 4) = b2;
            ss1 += (a.x * a.x + a.y * a.y) + (a.z * a.z + a.w * a.w) + (b2.x * b2.x + b2.y * b2.y) + (b2.z * b2.z + b2.w * b2.w); }
        const float r2 = rsqrtf(wave_sum(ss1) * (1.0f / D) + EPS);
#pragma unroll
        for (int j = 0; j < 4; ++j) { const int base = 8 * (lane + 64 * j); const f32x4 w0 = *(const f32x4*)(p.pre_ffn_w + base), w1 = *(const f32x4*)(p.pre_ffn_w + base + 4); const f32x4 a = x1[2 * j], b2 = x1[2 * j + 1];
            u32x4 o; o.x = pk2(a.x * r2 * w0.x, a.y * r2 * w0.y); o.y = pk2(a.z * r2 * w0.z, a.w * r2 * w0.w); o.z = pk2(b2.x * r2 * w1.x, b2.y * r2 * w1.y); o.w = pk2(b2.z * r2 * w1.z, b2.w * r2 * w1.w);
            *(u32x4*)(xn + base) = o; }
    }
    grid.sync();
    {
        pg8::Gemm g{XN, WGU, M, NGU, D}; pg8::StaticOrder S; S.init(M, NGU, G, (int)blockIdx.x); pg8::EpiSwiglu E{HID, DFF};
        pg8::gemm_phase<pg8::EpiSwiglu, pg8::StaticOrder, true, true>(lds, g, S, E);
    }
    grid.sync();
    {
        pg8::Gemm g{HID, WDN, M, D, DFF}; pg8::StaticOrder S; S.init(M, D, G, (int)blockIdx.x); pg8::EpiBf16 E{FF, D};
        pg8::gemm_phase<pg8::EpiBf16, pg8::StaticOrder, true, true>(lds, g, S, E);
    }
    grid.sync();
    for (int m = gw; m < M; m += NGW) {
        const bf16* fr = FF + (size_t)m * D; float* orow = p.out + (size_t)m * D;
        u32x4 mw[4]; float ss = 0.f;
#pragma unroll
        for (int j = 0; j < 4; ++j) { mw[j] = *(const u32x4*)(fr + 8 * (lane + 64 * j));
            const float a0 = bflo(mw[j].x), a1 = bfhi(mw[j].x), a2 = bflo(mw[j].y), a3 = bfhi(mw[j].y), a4 = bflo(mw[j].z), a5 = bfhi(mw[j].z), a6 = bflo(mw[j].w), a7 = bfhi(mw[j].w);
            ss += (a0 * a0 + a1 * a1) + (a2 * a2 + a3 * a3) + (a4 * a4 + a5 * a5) + (a6 * a6 + a7 * a7); }
        const float r1 = rsqrtf(wave_sum(ss) * (1.0f / D) + EPS);
#pragma unroll
        for (int j = 0; j < 4; ++j) { const int base = 8 * (lane + 64 * j);
            const f32x4 xa = *(const f32x4*)(orow + base), xb = *(const f32x4*)(orow + base + 4), wa = *(const f32x4*)(p.post_ffn_w + base), wb = *(const f32x4*)(p.post_ffn_w + base + 4);
            f32x4 a, b2;
            a.x = xa.x + bflo(mw[j].x) * r1 * wa.x; a.y = xa.y + bfhi(mw[j].x) * r1 * wa.y; a.z = xa.z + bflo(mw[j].y) * r1 * wa.z; a.w = xa.w + bfhi(mw[j].y) * r1 * wa.w;
            b2.x = xb.x + bflo(mw[j].z) * r1 * wb.x; b2.y = xb.y + bfhi(mw[j].z) * r1 * wb.y; b2.z = xb.z + bflo(mw[j].w) * r1 * wb.z; b2.w = xb.w + bfhi(mw[j].w) * r1 * wb.w;
            *(f32x4*)(orow + base) = a; *(f32x4*)(orow + base + 4) = b2; }
    }
}

extern "C" void kernel_launch(void* const* d_in, const int* in_sizes, int n_in, void* d_out, int out_size, void* d_ws, size_t ws_size, hipStream_t stream) {
    static int grid = 0;
    if (grid == 0) {
        if (n_in != 18 || in_sizes[0] != M * D || out_size != M * D || ws_size < WS_END) { fprintf(stderr, "kernel_launch: unexpected shapes (n_in %d, in0 %d, out %d, ws %zu)\n", n_in, n_in > 0 ? in_sizes[0] : -1, out_size, ws_size); grid = -1; return; }
        int dev = 0, cus = 0, per_cu = 0;
        if (hipGetDevice(&dev) != hipSuccess || hipDeviceGetAttribute(&cus, hipDeviceAttributeMultiprocessorCount, dev) != hipSuccess) { grid = -1; return; }
        if (hipFuncSetAttribute((const void*)fwd_kernel, hipFuncAttributeMaxDynamicSharedMemorySize, LDS_BYTES) != hipSuccess) { fprintf(stderr, "kernel_launch: hipFuncSetAttribute failed\n"); grid = -1; return; }
        if (hipOccupancyMaxActiveBlocksPerMultiprocessor(&per_cu, (const void*)fwd_kernel, 512, LDS_BYTES) != hipSuccess || per_cu < 1) { fprintf(stderr, "kernel_launch: occupancy query says %d\n", per_cu); per_cu = 1; }
        (void)hipGetLastError();
        grid = cus;
    }
    if (grid < 0) return;
    Params p{};
    p.x = (const float*)d_in[0]; p.pre_mix_w = (const float*)d_in[1]; p.w_in = (const float*)d_in[2]; p.lb_logits = (const float*)d_in[3]; p.conv_w = (const float*)d_in[4]; p.conv_b = (const float*)d_in[5];
    p.dt_bias = (const float*)d_in[6]; p.a_log = (const float*)d_in[7]; p.d_skip = (const float*)d_in[8]; p.hgrn_nw = (const float*)d_in[9]; p.ssd_nw = (const float*)d_in[10]; p.w_out = (const float*)d_in[11];
    p.post_mix_w = (const float*)d_in[12]; p.pre_ffn_w = (const float*)d_in[13]; p.w_gate = (const float*)d_in[14]; p.w_up = (const float*)d_in[15]; p.w_down = (const float*)d_in[16]; p.post_ffn_w = (const float*)d_in[17];
    p.out = (float*)d_out; p.ws = (unsigned char*)d_ws;
    void* args[] = {&p};
    hipError_t e = hipLaunchCooperativeKernel((const void*)fwd_kernel, dim3(grid), dim3(512), args, LDS_BYTES, stream);
    if (e != hipSuccess) fprintf(stderr, "kernel_launch: cooperative launch failed: %s (grid %d)\n", hipGetErrorString(e), grid);
}
```

```cpp
#include <hip/hip_runtime.h>
#include <hip/hip_cooperative_groups.h>
#include <cstdio>
#include <cstdint>
namespace cg = cooperative_groups;
namespace pg8 {
#define PG8_LAS __attribute__((address_space(3)))
typedef unsigned short bf16_t;
typedef short bf16x8 __attribute__((ext_vector_type(8)));
typedef float f32x4 __attribute__((ext_vector_type(4)));
typedef unsigned u32x4 __attribute__((ext_vector_type(4)));
constexpr int BM = 256, BK = 64, HALF = 128, HTB = HALF * BK * 2  , STAGE_BYTES = 8 * HTB, NXCD = 8, WGM = 8;

__host__ __device__ __forceinline__ int lds_byte(int r, int c) { const int st = (r >> 4) * 2 + (c >> 5), rr = r & 15, cc = c & 31, ob = rr * 64 + cc * 2; return st * 1024 + (ob ^ (((ob >> 9) & 1) << 5)); }
__host__ __device__ __forceinline__ void stage_rc(int b, int& R, int& C) { const int st = b / 1024, sb = b % 1024, swz = sb ^ (((sb >> 9) & 1) << 5); R = (st >> 1) * 16 + swz / 64; C = (st & 1) * 32 + (swz % 64) / 2; }
__host__ __device__ __forceinline__ int perm32(int rho) { const int n = rho >> 4, i = rho & 15; return 8 * (i >> 2) + 4 * n + (i & 3); }

struct Unit { int pm, pn; };
struct Gemm { const bf16_t* A; const bf16_t* Bt; int M, N, K; };

struct StaticOrder {
    int nM, nN, nwg, G, c;
    __host__ __device__ void init(int M, int N, int G_, int c_) { nM = M / BM; nN = N / BM; nwg = nM * nN; G = G_; c = c_; }
    __host__ __device__ bool next(int i, Unit& u) const {
        const long L = (long)i * G + c; if (L >= nwg) return false;
        int wgid = (int)L; { const int q = nwg / NXCD, r = nwg % NXCD, xcd = wgid % NXCD, off = wgid / NXCD; wgid = (xcd < r ? xcd * (q + 1) : r * (q + 1) + (xcd - r) * q) + off; }
        const int nig = WGM * nN, gid = wgid / nig, fm = gid * WGM, gsz = (nM - fm) < WGM ? (nM - fm) : WGM;
        u.pm = fm + ((wgid % nig) % gsz); u.pn = (wgid % nig) / gsz; return true;
    }
    __device__ __forceinline__ void a_ready(const Unit&) const {}
    __device__ __forceinline__ void done(const Unit&) const {}
};

__device__ __forceinline__ unsigned cvt_pk_bf16(float lo, float hi) { unsigned r; asm volatile("v_cvt_pk_bf16_f32 %0, %1, %2" : "=v"(r) : "v"(lo), "v"(hi)); return r; }
struct EpiBf16 {
    static constexpr bool PERM = true, AFTER_DRAIN = false;
    bf16_t* O; int ldc;
    __device__ __forceinline__ void operator()(const f32x4 (&acc)[2][2][4][2], const Unit& u, int wr, int wc, int fr, int fq) const {
        const int row0 = u.pm * BM + wr * 64 + fr; const int col0 = u.pn * BM + wc * 32 + 8 * fq;
#pragma unroll
        for (int ai = 0; ai < 2; ++ai)
#pragma unroll
            for (int m = 0; m < 4; ++m) { bf16_t* rowp = O + (size_t)(row0 + ai * HALF + m * 16) * ldc + col0;
#pragma unroll
                for (int bj = 0; bj < 2; ++bj) { const f32x4 v0 = acc[ai][bj][m][0], v1 = acc[ai][bj][m][1];
                    u32x4 w; w.x = cvt_pk_bf16(v0[0], v0[1]); w.y = cvt_pk_bf16(v0[2], v0[3]); w.z = cvt_pk_bf16(v1[0], v1[1]); w.w = cvt_pk_bf16(v1[2], v1[3]);
                    *(u32x4*)(rowp + bj * HALF) = w; } }
    }
};
__device__ __forceinline__ float silu_f(float v) { return v / (1.0f + __expf(-v)); }
struct EpiSwiglu {
    static constexpr bool PERM = true, AFTER_DRAIN = false;
    bf16_t* O; int ldc;
    __device__ __forceinline__ void operator()(const f32x4 (&acc)[2][2][4][2], const Unit& u, int wr, int wc, int fr, int fq) const {
        const int row0 = u.pm * BM + wr * 64 + fr; const int col0 = u.pn * HALF + wc * 32 + 8 * fq;
#pragma unroll
        for (int ai = 0; ai < 2; ++ai)
#pragma unroll
            for (int m = 0; m < 4; ++m) { bf16_t* rowp = O + (size_t)(row0 + ai * HALF + m * 16) * ldc + col0;
                const f32x4 g0 = acc[ai][0][m][0], g1 = acc[ai][0][m][1], u0 = acc[ai][1][m][0], u1 = acc[ai][1][m][1];
                u32x4 w; w.x = cvt_pk_bf16(silu_f(g0[0]) * u0[0], silu_f(g0[1]) * u0[1]); w.y = cvt_pk_bf16(silu_f(g0[2]) * u0[2], silu_f(g0[3]) * u0[3]);
                w.z = cvt_pk_bf16(silu_f(g1[0]) * u1[0], silu_f(g1[1]) * u1[1]); w.w = cvt_pk_bf16(silu_f(g1[2]) * u1[2], silu_f(g1[3]) * u1[3]);
                *(u32x4*)rowp = w; }
    }
};

template <class Epi, class Sched, bool ALIGN_EPI = false, bool SP2 = false>
__device__ __forceinline__ void gemm_phase(PG8_LAS unsigned char* lds, const Gemm g, const Sched& S, const Epi& E) {
    const int tid = threadIdx.x, wid = __builtin_amdgcn_readfirstlane(tid >> 6), lane = tid & 63, wr = wid >> 2, wc = wid & 3, fr = lane & 15, fq = lane >> 4;
    const int K = g.K, nt = K / BK;
    unsigned voffA[2], voffB[2];
#pragma unroll
    for (int i = 0; i < 2; ++i) { int R, C; stage_rc(tid * 16 + i * 8192, R, C); const int Rb = Epi::PERM ? ((R & ~31) + perm32(R & 31)) : R;
        voffA[i] = (unsigned)(R * K + C) * 2u; voffB[i] = (unsigned)(Rb * K + C) * 2u; }
    const size_t kstep = (size_t)(BK * 2);
    const size_t hstep = (size_t)HALF * K * 2;
    const size_t tstep = 2 * hstep;
    const unsigned ldsw = (unsigned)wid * 1024u;
    const int aoff = lds_byte(wr * 64 + fr, fq * 8), boff = lds_byte(wc * 32 + fr, fq * 8);
#define PG8_SA(b, h) (((b) * 2 + (h)) * HTB)
#define PG8_SB(b, h) ((4 + (b) * 2 + (h)) * HTB)
#define PG8_STAGE(bufoff, gbase, voff) do { _Pragma("unroll") for (int _i = 0; _i < 2; ++_i) \
        __builtin_amdgcn_global_load_lds((const unsigned*)((const char*)(gbase) + (voff)[_i]), (PG8_LAS unsigned*)(lds + (bufoff) + ldsw + _i * 8192), 16, 0, 0); } while (0)
#define PG8_LDA(dst, b, h) do { _Pragma("unroll") for (int m = 0; m < 4; ++m) _Pragma("unroll") for (int k = 0; k < 2; ++k) dst[m][k] = *(const PG8_LAS bf16x8*)(lds + PG8_SA(b, h) + aoff + m * 2048 + k * 1024); } while (0)
#define PG8_LDB(dst, b, h) do { _Pragma("unroll") for (int n = 0; n < 2; ++n) _Pragma("unroll") for (int k = 0; k < 2; ++k) dst[n][k] = *(const PG8_LAS bf16x8*)(lds + PG8_SB(b, h) + boff + n * 2048 + k * 1024); } while (0)
#define PG8_MMA(ai, bj, At, Bt) do { __builtin_amdgcn_s_setprio(1); _Pragma("unroll") for (int m = 0; m < 4; ++m) _Pragma("unroll") for (int n = 0; n < 2; ++n) _Pragma("unroll") for (int k = 0; k < 2; ++k) \
        acc[ai][bj][m][n] = __builtin_amdgcn_mfma_f32_16x16x32_bf16(Bt[n][k], At[m][k], acc[ai][bj][m][n], 0, 0, 0); __builtin_amdgcn_s_setprio(0); } while (0)
#define PG8_WAIT_V(n) asm volatile("s_waitcnt vmcnt(" #n ")" ::: "memory")
#define PG8_WAIT_L(n) asm volatile("s_waitcnt lgkmcnt(" #n ")" ::: "memory")
#define PG8_BAR __builtin_amdgcn_s_barrier()
#define PG8_SCHED __builtin_amdgcn_sched_barrier(0)
    Unit cur, nxt; int ui = 0;
    if (!S.next(0, cur)) return;
    f32x4 acc[2][2][4][2];
#pragma unroll
    for (int a = 0; a < 2; ++a)
#pragma unroll
        for (int b = 0; b < 2; ++b)
#pragma unroll
            for (int m = 0; m < 4; ++m)
#pragma unroll
                for (int n = 0; n < 2; ++n) acc[a][b][m][n] = (f32x4){0.f, 0.f, 0.f, 0.f};
    bf16x8 At[4][2], B0[2][2], B1[2][2];
    const char* cA = (const char*)g.A + (size_t)cur.pm * tstep; const char* cB = (const char*)g.Bt + (size_t)cur.pn * tstep;
    S.a_ready(cur);
    if constexpr (SP2) {
        PG8_STAGE(PG8_SB(0, 0), cB, voffB); PG8_STAGE(PG8_SB(0, 1), cB + hstep, voffB); PG8_STAGE(PG8_SA(0, 0), cA, voffA); PG8_STAGE(PG8_SA(0, 1), cA + hstep, voffA);
        if (wr == 1) PG8_BAR;
        PG8_WAIT_V(2); PG8_BAR;
        PG8_STAGE(PG8_SB(1, 0), cB + kstep, voffB); PG8_STAGE(PG8_SA(1, 0), cA + kstep, voffA); PG8_STAGE(PG8_SB(1, 1), cB + hstep + kstep, voffB);
        PG8_WAIT_V(6); PG8_BAR;
    } else {
        PG8_STAGE(PG8_SB(0, 0), cB, voffB); PG8_STAGE(PG8_SA(0, 0), cA, voffA); PG8_STAGE(PG8_SB(0, 1), cB + hstep, voffB); PG8_STAGE(PG8_SA(0, 1), cA + hstep, voffA);
        if (wr == 1) PG8_BAR;
        PG8_WAIT_V(4); PG8_BAR;
        PG8_STAGE(PG8_SB(1, 0), cB + kstep, voffB); PG8_STAGE(PG8_SA(1, 0), cA + kstep, voffA); PG8_STAGE(PG8_SB(1, 1), cB + hstep + kstep, voffB);
        PG8_WAIT_V(6); PG8_BAR;
    }
    for (;;) {
        const bool has_next = S.next(ui + 1, nxt);
        const char* nA = has_next ? (const char*)g.A + (size_t)nxt.pm * tstep : cA; const char* nB = has_next ? (const char*)g.Bt + (size_t)nxt.pn * tstep : cB;
        for (int t = 0; t < nt; t += 2) {
            const bool last = (t == nt - 2);
            const char* a1 = cA + (size_t)(t + 1) * kstep;
            const char* a2 = last ? nA : cA + (size_t)(t + 2) * kstep; const char* b2 = last ? nB : cB + (size_t)(t + 2) * kstep;
            const char* a3 = a2 + kstep; const char* b3 = b2 + kstep;
            if (last && has_next) S.a_ready(nxt);
            if constexpr (SP2) {
            PG8_LDB(B0, 0, 0); PG8_LDB(B1, 0, 1); PG8_SCHED; PG8_LDA(At, 0, 0); PG8_STAGE(PG8_SA(1, 1), a1 + hstep, voffA);
            PG8_WAIT_V(8); PG8_WAIT_L(0); PG8_BAR; PG8_MMA(0, 0, At, B0); PG8_MMA(0, 1, At, B1); PG8_BAR; PG8_SCHED;
            PG8_LDA(At, 0, 1); PG8_STAGE(PG8_SB(0, 0), b2, voffB); PG8_STAGE(PG8_SB(0, 1), b2 + hstep, voffB); PG8_STAGE(PG8_SA(0, 0), a2, voffA);
            PG8_WAIT_V(8); PG8_WAIT_L(0); PG8_BAR; PG8_MMA(1, 0, At, B0); PG8_MMA(1, 1, At, B1); PG8_BAR; PG8_SCHED;
            PG8_LDB(B0, 1, 0); PG8_LDB(B1, 1, 1); PG8_SCHED; PG8_LDA(At, 1, 0); PG8_STAGE(PG8_SA(0, 1), a2 + hstep, voffA);
            PG8_WAIT_V(8); PG8_WAIT_L(0); PG8_BAR; PG8_MMA(0, 0, At, B0); PG8_MMA(0, 1, At, B1); PG8_BAR; PG8_SCHED;
            PG8_LDA(At, 1, 1); PG8_STAGE(PG8_SB(1, 0), b3, voffB); PG8_STAGE(PG8_SB(1, 1), b3 + hstep, voffB); PG8_STAGE(PG8_SA(1, 0), a3, voffA);
            PG8_WAIT_V(8); PG8_WAIT_L(0); PG8_BAR; PG8_MMA(1, 0, At, B0); PG8_MMA(1, 1, At, B1); PG8_BAR; PG8_SCHED;
            } else {
            PG8_LDB(B0, 0, 0); PG8_SCHED; PG8_LDA(At, 0, 0); PG8_STAGE(PG8_SA(1, 1), a1 + hstep, voffA);
            PG8_WAIT_L(8); PG8_BAR; PG8_WAIT_L(0); PG8_MMA(0, 0, At, B0); PG8_BAR; PG8_SCHED;
            PG8_LDB(B1, 0, 1); PG8_STAGE(PG8_SB(0, 0), b2, voffB);
            PG8_BAR; PG8_WAIT_L(0); PG8_MMA(0, 1, At, B1); PG8_BAR;
            PG8_LDA(At, 0, 1); PG8_STAGE(PG8_SA(0, 0), a2, voffA);
            PG8_BAR; PG8_WAIT_L(0); PG8_MMA(1, 0, At, B0); PG8_BAR; PG8_SCHED;
            PG8_STAGE(PG8_SB(0, 1), b2 + hstep, voffB);
            PG8_WAIT_V(6); PG8_BAR; PG8_MMA(1, 1, At, B1); PG8_BAR;
            PG8_LDB(B0, 1, 0); PG8_SCHED; PG8_LDA(At, 1, 0); PG8_STAGE(PG8_SA(0, 1), a2 + hstep, voffA);
            PG8_WAIT_L(8); PG8_BAR; PG8_WAIT_L(0); PG8_MMA(0, 0, At, B0); PG8_BAR; PG8_SCHED;
            PG8_LDB(B1, 1, 1); PG8_STAGE(PG8_SB(1, 0), b3, voffB);
            PG8_BAR; PG8_WAIT_L(0); PG8_MMA(0, 1, At, B1); PG8_BAR;
            PG8_LDA(At, 1, 1); PG8_STAGE(PG8_SA(1, 0), a3, voffA);
            PG8_BAR; PG8_WAIT_L(0); PG8_MMA(1, 0, At, B0); PG8_BAR; PG8_SCHED;
            PG8_STAGE(PG8_SB(1, 1), b3 + hstep, voffB);
            PG8_WAIT_V(6); PG8_BAR; PG8_MMA(1, 1, At, B1); PG8_BAR;
            }
        }
        if constexpr (ALIGN_EPI) { if (wr == 0) PG8_BAR; }
        if constexpr (!Epi::AFTER_DRAIN) { E(acc, cur, wr, wc, fr, fq); S.done(cur); }
        if (!has_next) break;
#pragma unroll
        for (int a = 0; a < 2; ++a)
#pragma unroll
            for (int b = 0; b < 2; ++b)
#pragma unroll
                for (int m = 0; m < 4; ++m)
#pragma unroll
                    for (int n = 0; n < 2; ++n) acc[a][b][m][n] = (f32x4){0.f, 0.f, 0.f, 0.f};
        cur = nxt; cA = nA; cB = nB; ++ui;
        if constexpr (ALIGN_EPI) { if (wr == 1) PG8_BAR; }
    }
    PG8_WAIT_V(0);
    if constexpr (!ALIGN_EPI) { if (wr == 0) PG8_BAR; }
    PG8_BAR;
    if constexpr (Epi::AFTER_DRAIN) { E.fused(acc, cur, wr, wc, fr, fq, lds, wid, lane); S.done(cur); }
#undef PG8_SA
#undef PG8_SB
#undef PG8_STAGE
#undef PG8_LDA
#undef PG8_LDB
#undef PG8_MMA
#undef PG8_WAIT_V
#undef PG8_WAIT_L
#undef PG8_BAR
#undef PG8_SCHED
}
}

constexpr int BATCH = 2, SEQ = 8192, M = BATCH * SEQ, D = 2048;
constexpr int NIN = 6672, NINP = 6912, DFF = 5632, NGU = 2 * DFF;
constexpr int C_Q = 0, C_F = 1024, C_I = 2048, C_G = 3072, C_Z = 4096, C_XBC = 5120, C_DT = 6656;
constexpr int XBC_W = 1536;
constexpr float EPS = 1e-6f;
constexpr size_t MiB = 1u << 20;
constexpr size_t WS_CTL = 0, CTL_ZERO_BYTES = 65536;
constexpr size_t WS_WIN = 1 * MiB;
constexpr size_t WS_WOUT = 28 * MiB;
constexpr size_t WS_WGU = 36 * MiB;
constexpr size_t WS_WDN = 80 * MiB;
constexpr size_t WS_XN = 102 * MiB;
constexpr size_t WS_PROJ = 166 * MiB;
constexpr size_t WS_ST = 382 * MiB;
constexpr size_t WS_DEC = 478 * MiB;
constexpr size_t WS_END = 480 * MiB;
constexpr int LDS_BYTES = 147456;

#define LAS __attribute__((address_space(3)))
typedef unsigned short bf16;
typedef float f32x4 __attribute__((ext_vector_type(4)));
typedef unsigned u32x4 __attribute__((ext_vector_type(4)));
#define LDS_WAIT() asm volatile("s_waitcnt lgkmcnt(0)" ::: "memory")
__device__ __forceinline__ float bf2f(unsigned short u) { return __uint_as_float(((unsigned)u) << 16); }
__device__ __forceinline__ unsigned f2bf(float f) { unsigned u = __float_as_uint(f); return (u + 0x7fffu + ((u >> 16) & 1u)) >> 16; }
__device__ __forceinline__ unsigned pk2(float lo, float hi) { return f2bf(lo) | (f2bf(hi) << 16); }
__device__ __forceinline__ float bflo(unsigned w) { return __uint_as_float(w << 16); }
__device__ __forceinline__ float bfhi(unsigned w) { return __uint_as_float(w & 0xffff0000u); }
__device__ __forceinline__ float wave_sum(float v) {
#pragma unroll
    for (int o = 1; o < 64; o <<= 1) v += __shfl_xor(v, o);
    return v;
}
__device__ __forceinline__ float sigm(float x) { return 1.0f / (1.0f + __expf(-x)); }
__device__ __forceinline__ float silu(float x) { return x / (1.0f + __expf(-x)); }

struct Params {
    const float *x, *pre_mix_w, *w_in, *lb_logits, *conv_w, *conv_b, *dt_bias, *a_log, *d_skip, *hgrn_nw, *ssd_nw, *w_out, *post_mix_w, *pre_ffn_w, *w_gate, *w_up, *w_down, *post_ffn_w;
    float* out; unsigned char* ws;
};

__device__ __forceinline__ void transpose_item(const float* W, int K, int N, bf16* WT, int k0, int n0, int rowb, LAS float* scr, int lane) {
    const int n_in = n0 + (lane & 31);
#pragma unroll 8
    for (int i = 0; i < 32; ++i) { const int kk = 2 * i + (lane >> 5); scr[kk * 33 + (lane & 31)] = (n_in < N) ? W[(size_t)(k0 + kk) * N + n_in] : 0.f; }
    LDS_WAIT();
    const int c = lane & 7;
#pragma unroll
    for (int j = 0; j < 4; ++j) { const int n = (lane >> 3) + 8 * j; const LAS float* s = scr + (8 * c) * 33 + n;
        u32x4 o; o.x = pk2(s[0 * 33], s[1 * 33]); o.y = pk2(s[2 * 33], s[3 * 33]); o.z = pk2(s[4 * 33], s[5 * 33]); o.w = pk2(s[6 * 33], s[7 * 33]);
        *(u32x4*)(WT + (size_t)(rowb + n) * K + k0 + 8 * c) = o; }
    LDS_WAIT();
}
__device__ __forceinline__ void rms_row_to_bf16(const float* xrow, const float* w, bf16* orow, int lane) {
    f32x4 v[8]; float ss = 0.f;
#pragma unroll
    for (int j = 0; j < 4; ++j) { const int base = 8 * (lane + 64 * j); v[2 * j] = *(const f32x4*)(xrow + base); v[2 * j + 1] = *(const f32x4*)(xrow + base + 4);
        const f32x4 a = v[2 * j], b = v[2 * j + 1]; ss += (a.x * a.x + a.y * a.y) + (a.z * a.z + a.w * a.w) + (b.x * b.x + b.y * b.y) + (b.z * b.z + b.w * b.w); }
    const float r = rsqrtf(wave_sum(ss) * (1.0f / D) + EPS);
#pragma unroll
    for (int j = 0; j < 4; ++j) { const int base = 8 * (lane + 64 * j); const f32x4 w0 = *(const f32x4*)(w + base), w1 = *(const f32x4*)(w + base + 4); const f32x4 a = v[2 * j], b = v[2 * j + 1];
        u32x4 o; o.x = pk2(a.x * r * w0.x, a.y * r * w0.y); o.y = pk2(a.z * r * w0.z, a.w * r * w0.w); o.z = pk2(b.x * r * w1.x, b.y * r * w1.y); o.w = pk2(b.z * r * w1.z, b.w * r * w1.w);
        *(u32x4*)(orow + base) = o; }
}

#define XB_TMO      128
#define XB_XCNT(j)  (256  + 64 * (j))
#define XB_XSUB(j)  (1280 + 64 * (j))
#define XB_XGEN(j)  (2304 + 64 * (j))
#define XB_TOP      3328
#define XB_TOPGEN   3392
#define XCD_BAR_WORDS 3456
#define XB_SPIN_CAP (1u << 18)

__device__ __forceinline__ unsigned xb_ld(unsigned* p)              { return __hip_atomic_load(p, __ATOMIC_RELAXED, __HIP_MEMORY_SCOPE_AGENT); }
__device__ __forceinline__ unsigned xb_add(unsigned* p, unsigned v) { return __hip_atomic_fetch_add(p, v, __ATOMIC_RELAXED, __HIP_MEMORY_SCOPE_AGENT); }
__device__ __forceinline__ unsigned xb_xcc_id() { return (unsigned)__builtin_amdgcn_s_getreg((3 << 11) | 20) & 0xFu; }
#define XB_SPIN(cond, bar) do { unsigned _sp = 0; while (cond) { __builtin_amdgcn_s_sleep(1); \
    if ((++_sp & 255u) == 0u) { if (xb_ld(&(bar)[XB_TMO])) break; if (_sp > XB_SPIN_CAP) { atomicAdd(&(bar)[XB_TMO], 1u); break; } } } } while (0)

struct XcdBarrier {
    unsigned* bar; unsigned x;
    volatile LAS unsigned* st;
};

__device__ __forceinline__ XcdBarrier xcd_barrier_post(unsigned* bar, volatile LAS unsigned* st) {
    XcdBarrier b; b.bar = bar; b.x = xb_xcc_id(); b.st = st;
    if (threadIdx.x == 0) (void)xb_add(&bar[XB_XCNT(b.x)], 1u);
    return b;
}
__device__ __forceinline__ void xcd_barrier_complete(unsigned* bar, unsigned x, unsigned& nloc, unsigned& nx) {
    const unsigned G = gridDim.x * gridDim.y * gridDim.z;
    unsigned sum, cnt, mine, sp = 0u;
    for (;;) {
        sum = 0u; cnt = 0u; mine = 0u;
#pragma unroll
        for (unsigned j = 0; j < 16; ++j) { const unsigned c = xb_ld(&bar[XB_XCNT(j)]); sum += c; cnt += (c > 0u) ? 1u : 0u; mine = (j == x) ? c : mine; }
        if (sum == G) break;
        __builtin_amdgcn_s_sleep(1);
        if ((++sp & 255u) == 0u) { if (xb_ld(&bar[XB_TMO])) break; if (sp > XB_SPIN_CAP) { atomicAdd(&bar[XB_TMO], 1u); break; } }
    }
    nloc = mine > 0u ? mine : 1u; nx = cnt > 0u ? cnt : 1u;
}

__device__ __forceinline__ void xcd_barrier(const XcdBarrier& b) {
    asm volatile("s_waitcnt vmcnt(0)" ::: "memory");
    __syncthreads();
    if (threadIdx.x == 0) {
        unsigned* bar = b.bar;
        __builtin_amdgcn_s_waitcnt(0);
        unsigned nloc = b.st[0], nx = b.st[1];
        if (nloc == 0u) { xcd_barrier_complete(bar, b.x, nloc, nx); b.st[0] = nloc; b.st[1] = nx; }
        const unsigned old = xb_add(&bar[XB_XSUB(b.x)], 1u);
        const unsigned gen = old / nloc;
        if (old + 1u == (gen + 1u) * nloc) {
            __builtin_amdgcn_fence(__ATOMIC_RELEASE, "agent");
            asm volatile("s_waitcnt vmcnt(0)" ::: "memory");
            const unsigned og = xb_add(&bar[XB_TOP], 1u);
            const unsigned tg = og / nx;
            if (og + 1u == (tg + 1u) * nx) xb_add(&bar[XB_TOPGEN], 1u);
            else XB_SPIN(xb_ld(&bar[XB_TOPGEN]) == tg, bar);
            __builtin_amdgcn_fence(__ATOMIC_ACQUIRE, "agent");
            xb_add(&bar[XB_XGEN(b.x)], 1u);
            asm volatile("s_waitcnt vmcnt(0)" ::: "memory");
        } else {
            XB_SPIN(xb_ld(&bar[XB_XGEN(b.x)]) == gen, bar);
            __builtin_amdgcn_fence(__ATOMIC_ACQUIRE, "agent");
            asm volatile("s_waitcnt vmcnt(0)" ::: "memory");
        }
    }
    __syncthreads();
}
__device__ __forceinline__ void naive_hgrn(LAS unsigned char* lds, const Params& p, int bh) {
    const int tid = threadIdx.x, lane = tid & 63, wave = tid >> 6, quarter = tid >> 7, v = tid & 127;
    const int b = bh >> 3, h = bh & 7;
    const bf16* proj = (const bf16*)(p.ws + WS_PROJ); bf16* mixin = (bf16*)(p.ws + WS_XN);
    LAS float* fq = (LAS float*)lds; LAS float* qq = fq + 2048; LAS float* part = qq + 2048;
    float S[32];
#pragma unroll
    for (int i = 0; i < 32; ++i) S[i] = 0.f;
    for (int t0 = 0; t0 < SEQ; t0 += 16) {
        const size_t rowb = (size_t)b * SEQ + t0;
        for (int e = tid; e < 2048; e += 512) { const int tt = e >> 7, k = e & 127; const bf16* pr = proj + (rowb + tt) * NINP + h * 128 + k;
            const float qr = bf2f(pr[C_Q]), fr = bf2f(pr[C_F]); const float l0 = p.lb_logits[h * 128 + k], l1 = p.lb_logits[1024 + h * 128 + k]; const float lb = 1.0f / (1.0f + expf(l1 - l0));
            fq[e] = lb + (1.0f - lb) * sigm(fr); qq[e] = silu(qr) * 0.08838834764831845f; }
        __syncthreads();
        for (int tt = 0; tt < 16; ++tt) { const float iv = bf2f(proj[(rowb + tt) * NINP + C_I + h * 128 + v]); float acc = 0.f;
#pragma unroll
            for (int kk = 0; kk < 32; ++kk) { const float f = fq[tt * 128 + quarter * 32 + kk]; S[kk] = f * S[kk] + (1.0f - f) * iv; acc += S[kk] * qq[tt * 128 + quarter * 32 + kk]; }
            part[(quarter * 16 + tt) * 128 + v] = acc; }
        __syncthreads();
        for (int tt = 2 * wave; tt < 2 * wave + 2; ++tt) {
            float o0 = 0.f, o1 = 0.f;
#pragma unroll
            for (int q = 0; q < 4; ++q) { o0 += part[(q * 16 + tt) * 128 + lane]; o1 += part[(q * 16 + tt) * 128 + 64 + lane]; }
            const float r = rsqrtf(wave_sum(o0 * o0 + o1 * o1) * (1.0f / 128.0f) + EPS);
            const bf16* pr = proj + (rowb + tt) * NINP + C_G + h * 128; const float g0 = bf2f(pr[lane]), g1 = bf2f(pr[64 + lane]);
            bf16* mo = mixin + (rowb + tt) * 2048 + h * 128;
            mo[lane] = (bf16)f2bf(o0 * r * p.hgrn_nw[h * 128 + lane] * silu(g0)); mo[64 + lane] = (bf16)f2bf(o1 * r * p.hgrn_nw[h * 128 + 64 + lane] * silu(g1));
        }
        __syncthreads();
    }
}
__device__ __forceinline__ void naive_ssd(LAS unsigned char* lds, const Params& p, int bg) {
    const int tid = threadIdx.x, lane = tid & 63, wave = tid >> 6;
    const int b = bg >> 1, g = bg & 1, hh = wave, head = g * 8 + hh, pp = lane;
    const bf16* proj = (const bf16*)(p.ws + WS_PROJ); bf16* mixin = (bf16*)(p.ws + WS_XN);
    LAS float* Bs = (LAS float*)lds; LAS float* Cs = Bs + 2048; LAS float* xs = Cs + 2048; LAS float* yb = xs + 8192; LAS float* dtl = yb + 8192;
    float hst[128];
#pragma unroll
    for (int i = 0; i < 128; ++i) hst[i] = 0.f;
    const float A = -expf(p.a_log[head]), Dk = p.d_skip[head];
    for (int t0 = 0; t0 < SEQ; t0 += 16) {
        const size_t rowb = (size_t)b * SEQ + t0;
        for (int e = tid; e < 16 * 768; e += 512) { const int tt = e / 768, ch = e - tt * 768;
            const int col = ch < 512 ? g * 512 + ch : (ch < 640 ? 1024 + g * 128 + (ch - 512) : 1280 + g * 128 + (ch - 640));
            float acc = p.conv_b[col];
#pragma unroll
            for (int kk = 0; kk < 4; ++kk) { const int ts = t0 + tt - 3 + kk; if (ts >= 0) acc += p.conv_w[kk * XBC_W + col] * bf2f(proj[((size_t)b * SEQ + ts) * NINP + C_XBC + col]); }
            const float val = silu(acc);
            if (ch < 512) xs[tt * 512 + ch] = val; else if (ch < 640) Bs[tt * 128 + ch - 512] = val; else Cs[tt * 128 + ch - 640] = val; }
        if (tid < 128) { const int tt = tid >> 3, h8 = tid & 7; const float xr = bf2f(proj[(rowb + tt) * NINP + C_DT + g * 8 + h8]) + p.dt_bias[g * 8 + h8]; dtl[tid] = xr > 20.f ? xr : log1pf(expf(xr)); }
        __syncthreads();
        for (int tt = 0; tt < 16; ++tt) { const float dt = dtl[tt * 8 + hh], dA = expf(dt * A), xv = xs[tt * 512 + hh * 64 + pp], xdt = xv * dt; float y = 0.f;
#pragma unroll
            for (int n = 0; n < 128; ++n) { hst[n] = dA * hst[n] + xdt * Bs[tt * 128 + n]; y += Cs[tt * 128 + n] * hst[n]; }
            y += Dk * xv; const float z = bf2f(proj[(rowb + tt) * NINP + C_Z + head * 64 + pp]); yb[tt * 512 + hh * 64 + pp] = y * silu(z); }
        __syncthreads();
        for (int tt = 2 * wave; tt < 2 * wave + 2; ++tt) {
            float yv[8]; float ss = 0.f;
#pragma unroll
            for (int j = 0; j < 8; ++j) { yv[j] = yb[tt * 512 + lane + 64 * j]; ss += yv[j] * yv[j]; }
            const float r = rsqrtf(wave_sum(ss) * (1.0f / 512.0f) + EPS);
            bf16* mo = mixin + (rowb + tt) * 2048 + 1024 + g * 512;
#pragma unroll
            for (int j = 0; j < 8; ++j) mo[lane + 64 * j] = (bf16)f2bf(yv[j] * r * p.ssd_nw[g * 512 + lane + 64 * j]);
        }
        __syncthreads();
    }
}

constexpr size_t WS_ST_S = WS_ST + 64 * MiB;
constexpr size_t WS_DEC_S = WS_DEC + 1 * MiB;
typedef short bf16x8 __attribute__((ext_vector_type(8)));
typedef unsigned u32x2 __attribute__((ext_vector_type(2)));
__device__ __forceinline__ f32x4 mma_lds(const LAS bf16* A, int lda, const LAS bf16* Bt, int ldb, int K, f32x4 acc, int lane) {
    const int r = lane & 15, q = lane >> 4;
    for (int k0 = 0; k0 < K; k0 += 32) {
        const bf16x8 a = *(const LAS bf16x8*)(A + r * lda + k0 + 8 * q);
        const bf16x8 b = *(const LAS bf16x8*)(Bt + r * ldb + k0 + 8 * q);
        acc = __builtin_amdgcn_mfma_f32_16x16x32_bf16(a, b, acc, 0, 0, 0);
    }
    return acc;
}
__device__ __forceinline__ f32x4 mma_lds_glb(const LAS bf16* A, int lda, const bf16* Bt, int ldb, int K, f32x4 acc, int lane) {
    const int r = lane & 15, q = lane >> 4;
    for (int k0 = 0; k0 < K; k0 += 32) {
        const bf16x8 a = *(const LAS bf16x8*)(A + r * lda + k0 + 8 * q);
        const bf16x8 b = *(const bf16x8*)(Bt + (size_t)r * ldb + k0 + 8 * q);
        acc = __builtin_amdgcn_mfma_f32_16x16x32_bf16(a, b, acc, 0, 0, 0);
    }
    return acc;
}
__device__ __forceinline__ float softplus(float x) { return x > 20.f ? x : log1pf(expf(x)); }

template <bool OUT>
__device__ __forceinline__ void hgrn_unit(LAS unsigned char* lds, const Params& p, int u) {
    const int tid = threadIdx.x, lane = tid & 63, wave = tid >> 6, I = tid >> 7, k = tid & 127, r = lane & 15, q = lane >> 4;
    const int b = u >> 10, c = (u >> 3) & 127, h = u & 7;
    const size_t row0 = (size_t)b * SEQ + c * 64;
    const bf16* proj = (const bf16*)(p.ws + WS_PROJ);
    const int uh = (b * 8 + h) * 128 + c;
    bf16* ST = (bf16*)(p.ws + WS_ST) + (size_t)uh * 16384;
    LAS float* Tsum = (LAS float*)lds;
    LAS bf16* vT = (LAS bf16*)(lds + 2048);
    LAS bf16* KdT = (LAS bf16*)(lds + 20480);
    LAS bf16* Qt = (LAS bf16*)(lds + 20480);
    LAS bf16* Qb = Qt + 64 * 136;
    LAS bf16* KT = Qb + 64 * 136;
    LAS bf16* P = KT + 160 * 136;
    LAS float* red = (LAS float*)(P + 64 * 72);
    const float l0 = p.lb_logits[h * 128 + k], l1 = p.lb_logits[1024 + h * 128 + k]; const float lb = 1.0f / (1.0f + expf(l1 - l0));
    float bl[16], kk[16], qv[16];
    {
        const bf16* pr = proj + (row0 + 16 * I) * NINP + h * 128 + k; float run = 0.f;
#pragma unroll
        for (int j = 0; j < 16; ++j) { const float fr = bf2f(pr[(size_t)j * NINP + C_F]); const float fg = lb + (1.0f - lb) * sigm(fr); run += logf(fg); bl[j] = run; kk[j] = 1.0f - fg;
            if (OUT) { const float qr = bf2f(pr[(size_t)j * NINP + C_Q]); qv[j] = silu(qr) * 0.08838834764831845f; } else qv[j] = 0.f; }
        Tsum[I * 128 + k] = run;
        const bf16* pv = pr + C_I; unsigned w[8];
#pragma unroll
        for (int j2 = 0; j2 < 8; ++j2) w[j2] = (unsigned)pv[(size_t)(2 * j2) * NINP] | ((unsigned)pv[(size_t)(2 * j2 + 1) * NINP] << 16);
        LAS u32x4* dst = (LAS u32x4*)(vT + k * 72 + 16 * I); dst[0] = (u32x4){w[0], w[1], w[2], w[3]}; dst[1] = (u32x4){w[4], w[5], w[6], w[7]};
    }
    __syncthreads();
    const float T0 = Tsum[k], T1 = Tsum[128 + k], T2 = Tsum[256 + k], T3 = Tsum[384 + k];
    const float start = (I > 0 ? T0 : 0.f) + (I > 1 ? T1 : 0.f) + (I > 2 ? T2 : 0.f), btot = (T0 + T1) + (T2 + T3);
    if (!OUT) {
        unsigned w[8]; const float e0 = btot - start;
#pragma unroll
        for (int j2 = 0; j2 < 8; ++j2) w[j2] = pk2(kk[2 * j2] * __expf(e0 - bl[2 * j2]), kk[2 * j2 + 1] * __expf(e0 - bl[2 * j2 + 1]));
        LAS u32x4* dst = (LAS u32x4*)(KdT + k * 72 + 16 * I); dst[0] = (u32x4){w[0], w[1], w[2], w[3]}; dst[1] = (u32x4){w[4], w[5], w[6], w[7]};
        if (I == 0) ((float*)(p.ws + WS_DEC))[(size_t)uh * 128 + k] = __expf(btot);
        __syncthreads();
#pragma unroll
        for (int n = 0; n < 8; ++n) {
            const f32x4 acc = mma_lds(KdT + 16 * wave * 72, 72, vT + 16 * n * 72, 72, 64, (f32x4){0.f, 0.f, 0.f, 0.f}, lane);
            *(u32x2*)(ST + (16 * n + r) * 128 + 16 * wave + 4 * q) = (u32x2){pk2(acc[0], acc[1]), pk2(acc[2], acc[3])};
        }
        __syncthreads();
        return;
    }
    {
        const float es = __expf(start);
#pragma unroll
        for (int j = 0; j < 16; ++j) { const int t = 16 * I + j; const float e1 = qv[j] * __expf(bl[j]); Qt[t * 136 + k] = (bf16)f2bf(e1); Qb[t * 136 + k] = (bf16)f2bf(e1 * es); }
        float Dacc = 0.f;
#pragma unroll
        for (int I2 = 0; I2 < 4; ++I2) {
            if (I2 >= I) { const int pair = I2 * (I2 + 1) / 2 + I;
#pragma unroll
                for (int j = 0; j < 16; ++j) KT[(pair * 16 + j) * 136 + k] = (bf16)f2bf(kk[j] * __expf(Dacc - bl[j]));
                Dacc += (I2 == 0 ? T0 : I2 == 1 ? T1 : I2 == 2 ? T2 : T3); }
        }
    }
    __syncthreads();
    {
        const int I2 = wave >> 1;
#pragma unroll
        for (int jj = 0; jj < 2; ++jj) { const int J = 2 * (wave & 1) + jj; f32x4 sc = (f32x4){0.f, 0.f, 0.f, 0.f};
            if (J <= I2) { const int pair = I2 * (I2 + 1) / 2 + J; sc = mma_lds(Qt + 16 * I2 * 136, 136, KT + pair * 16 * 136, 136, 128, sc, lane);
                if (J == I2) {
#pragma unroll
                    for (int j = 0; j < 4; ++j) if (r > 4 * q + j) sc[j] = 0.f; } }
#pragma unroll
            for (int j = 0; j < 4; ++j) P[(16 * I2 + 4 * q + j) * 72 + 16 * J + r] = (bf16)f2bf(sc[j]); }
    }
    __syncthreads();
    {
        const int rt = wave >> 1; f32x4 o[4]; float ssq[4] = {0.f, 0.f, 0.f, 0.f};
#pragma unroll
        for (int c4 = 0; c4 < 4; ++c4) { const int n = 4 * (wave & 1) + c4;
            f32x4 acc = mma_lds(P + 16 * rt * 72, 72, vT + 16 * n * 72, 72, 64, (f32x4){0.f, 0.f, 0.f, 0.f}, lane);
            acc = mma_lds_glb(Qb + 16 * rt * 136, 136, ST + (size_t)(16 * n) * 128, 128, 128, acc, lane);
            o[c4] = acc;
#pragma unroll
            for (int j = 0; j < 4; ++j) ssq[j] += acc[j] * acc[j]; }
#pragma unroll
        for (int j = 0; j < 4; ++j) { float s = ssq[j]; s += __shfl_xor(s, 1); s += __shfl_xor(s, 2); s += __shfl_xor(s, 4); s += __shfl_xor(s, 8); if (r == 0) red[(16 * rt + 4 * q + j) * 2 + (wave & 1)] = s; }
        __syncthreads();
        bf16* mixin = (bf16*)(p.ws + WS_XN);
#pragma unroll
        for (int j = 0; j < 4; ++j) { const int t = 16 * rt + 4 * q + j; const float rs = rsqrtf((red[t * 2] + red[t * 2 + 1]) * (1.0f / 128.0f) + EPS);
#pragma unroll
            for (int c4 = 0; c4 < 4; ++c4) { const int v = 16 * (4 * (wave & 1) + c4) + r; const float gg = bf2f(proj[(row0 + t) * NINP + C_G + h * 128 + v]);
                mixin[(row0 + t) * 2048 + h * 128 + v] = (bf16)f2bf(o[c4][j] * rs * p.hgrn_nw[h * 128 + v] * silu(gg)); } }
    }
    __syncthreads();
}

template <bool OUT>
__device__ __forceinline__ void ssd_unit(LAS unsigned char* lds, const Params& p, int u) {
    const int tid = threadIdx.x, lane = tid & 63, wave = tid >> 6, r = lane & 15, q = lane >> 4;
    const int b = u >> 7, c = (u >> 1) & 63, g = u & 1;
    const size_t row0 = (size_t)b * SEQ + c * 128;
    const bf16* proj = (const bf16*)(p.ws + WS_PROJ); bf16* mixin = (bf16*)(p.ws + WS_XN);
    LAS float* acs = (LAS float*)lds;
    LAS float* dtl = acs + 1024;
    LAS bf16* Cn = (LAS bf16*)(lds + 8192);
    LAS bf16* Bn = Cn + 128 * 136;
    LAS bf16* xT = Bn + 128 * 136;
    LAS bf16* xsN = xT + 64 * 136;
    LAS float* red = (LAS float*)(xsN + 128 * 72);
    {
        const int head = g * 8 + wave; const float A = -expf(p.a_log[head]), db = p.dt_bias[head];
        const float d0 = softplus(bf2f(proj[(row0 + lane) * NINP + C_DT + head]) + db), d1 = softplus(bf2f(proj[(row0 + 64 + lane) * NINP + C_DT + head]) + db);
        float a0 = d0 * A, a1 = d1 * A;
#pragma unroll
        for (int o = 1; o < 64; o <<= 1) { const float t0 = __shfl_up(a0, o), t1 = __shfl_up(a1, o); if (lane >= o) { a0 += t0; a1 += t1; } }
        a1 += __shfl(a0, 63);
        acs[wave * 128 + lane] = a0; acs[wave * 128 + 64 + lane] = a1; dtl[wave * 128 + lane] = d0; dtl[wave * 128 + 64 + lane] = d1;
        if (!OUT && lane == 63) ((float*)(p.ws + WS_DEC_S))[(b * 16 + head) * 64 + c] = __expf(a1);
    }
    {
        const int ch = tid & 127, which = (tid >> 7) & 1, seg = tid >> 8;
        if (OUT || which == 0) {
            const int col = 1024 + which * 256 + g * 128 + ch, tb = 64 * seg;
            const bf16* pc = proj + row0 * NINP + C_XBC + col;
            const float w0 = p.conv_w[col], w1 = p.conv_w[XBC_W + col], w2 = p.conv_w[2 * XBC_W + col], w3 = p.conv_w[3 * XBC_W + col], bias = p.conv_b[col];
            const bool hal = (c * 128 + tb) > 0;
            float r0 = hal ? bf2f(pc[(long)(tb - 3) * NINP]) : 0.f, r1 = hal ? bf2f(pc[(long)(tb - 2) * NINP]) : 0.f, r2 = hal ? bf2f(pc[(long)(tb - 1) * NINP]) : 0.f;
            LAS bf16* dstn = (which == 0 ? Bn : Cn);
            const bf16* pcc = pc + (long)tb * NINP;
#pragma unroll 4
            for (int i = 0; i < 64; ++i, pcc += NINP) { const float r3 = bf2f(*pcc); const float val = silu(bias + w0 * r0 + w1 * r1 + w2 * r2 + w3 * r3); r0 = r1; r1 = r2; r2 = r3;
                if (OUT) dstn[(tb + i) * 136 + ch] = (bf16)f2bf(val); else Cn[ch * 136 + tb + i] = (bf16)f2bf(val); }
        }
    }
    __syncthreads();
    f32x4 cb[8];
    if (OUT) {
#pragma unroll
        for (int n8 = 0; n8 < 8; ++n8) cb[n8] = mma_lds(Cn + 16 * wave * 136, 136, Bn + 16 * n8 * 136, 136, 128, (f32x4){0.f, 0.f, 0.f, 0.f}, lane);
        __syncthreads();
    }
    float ssq[4] = {0.f, 0.f, 0.f, 0.f};
    for (int hh = 0; hh < 8; ++hh) {
        const int head = g * 8 + hh;
        {
            const int pp = tid & 63, seg = tid >> 6, col = g * 512 + hh * 64 + pp, tb = 16 * seg;
            const bf16* pc = proj + row0 * NINP + C_XBC + col;
            const float w0 = p.conv_w[col], w1 = p.conv_w[XBC_W + col], w2 = p.conv_w[2 * XBC_W + col], w3 = p.conv_w[3 * XBC_W + col], bias = p.conv_b[col];
            const bool hal = (c * 128 + tb) > 0;
            float r0 = hal ? bf2f(pc[(long)(tb - 3) * NINP]) : 0.f, r1 = hal ? bf2f(pc[(long)(tb - 2) * NINP]) : 0.f, r2 = hal ? bf2f(pc[(long)(tb - 1) * NINP]) : 0.f;
            const float alast = acs[hh * 128 + 127];
            unsigned w[8]; float prev = 0.f;
            const bf16* pcc = pc + (long)tb * NINP;
#pragma unroll
            for (int i = 0; i < 16; ++i, pcc += NINP) { const float r3 = bf2f(*pcc); const float val = silu(bias + w0 * r0 + w1 * r1 + w2 * r2 + w3 * r3); r0 = r1; r1 = r2; r2 = r3;
                const int s = tb + i; float xv = val * dtl[hh * 128 + s];
                if (OUT) xsN[s * 72 + pp] = (bf16)f2bf(val); else xv *= __expf(alast - acs[hh * 128 + s]);
                if (i & 1) w[i >> 1] = pk2(prev, xv); else prev = xv; }
            LAS u32x4* dst = (LAS u32x4*)(xT + pp * 136 + tb); dst[0] = (u32x4){w[0], w[1], w[2], w[3]}; dst[1] = (u32x4){w[4], w[5], w[6], w[7]};
        }
        if (OUT) {
            LAS bf16* W = Bn;
#pragma unroll
            for (int n8 = 0; n8 < 8; ++n8)
#pragma unroll
                for (int j = 0; j < 4; ++j) { const int t = 16 * wave + 4 * q + j, s = 16 * n8 + r;
                    const float val = (s <= t) ? cb[n8][j] * __expf(acs[hh * 128 + t] - acs[hh * 128 + s]) : 0.f; W[t * 136 + s] = (bf16)f2bf(val); }
        }
        __syncthreads();
        if (OUT) {
            const bf16* prevS = (const bf16*)(p.ws + WS_ST_S) + (size_t)((b * 16 + head) * 64 + c) * 8192; const float Dk = p.d_skip[head];
#pragma unroll 1
            for (int c4 = 0; c4 < 4; ++c4) {
                const f32x4 accd = mma_lds(Bn + 16 * wave * 136, 136, xT + 16 * c4 * 136, 136, 128, (f32x4){0.f, 0.f, 0.f, 0.f}, lane);
                const f32x4 acco = mma_lds_glb(Cn + 16 * wave * 136, 136, prevS + (size_t)(16 * c4) * 128, 128, 128, (f32x4){0.f, 0.f, 0.f, 0.f}, lane);
#pragma unroll
                for (int j = 0; j < 4; ++j) { const int t = 16 * wave + 4 * q + j, pcol = 16 * c4 + r;
                    float y = accd[j] + __expf(acs[hh * 128 + t]) * acco[j] + Dk * bf2f(xsN[t * 72 + pcol]);
                    const float z = bf2f(proj[(row0 + t) * NINP + C_Z + head * 64 + pcol]); y *= silu(z); ssq[j] += y * y;
                    mixin[(row0 + t) * 2048 + 1024 + g * 512 + hh * 64 + pcol] = (bf16)f2bf(y * p.ssd_nw[g * 512 + hh * 64 + pcol]); }
            }
        } else {
            bf16* Lst = (bf16*)(p.ws + WS_ST_S) + (size_t)((b * 16 + head) * 64 + c) * 8192;
#pragma unroll
            for (int c4 = 0; c4 < 4; ++c4) {
                const f32x4 acc = mma_lds(Cn + 16 * wave * 136, 136, xT + 16 * c4 * 136, 136, 128, (f32x4){0.f, 0.f, 0.f, 0.f}, lane);
                *(u32x2*)(Lst + (16 * c4 + r) * 128 + 16 * wave + 4 * q) = (u32x2){pk2(acc[0], acc[1]), pk2(acc[2], acc[3])};
            }
        }
        __syncthreads();
    }
    if (OUT) {
#pragma unroll
        for (int j = 0; j < 4; ++j) { float s = ssq[j]; s += __shfl_xor(s, 1); s += __shfl_xor(s, 2); s += __shfl_xor(s, 4); s += __shfl_xor(s, 8); if (r == 0) red[16 * wave + 4 * q + j] = rsqrtf(s * (1.0f / 512.0f) + EPS); }
        __syncthreads();
        for (int e = tid; e < 128 * 64; e += 512) { const int t = e >> 6, c8 = e & 63; const float rs = red[t];
            u32x4* ptr = (u32x4*)(mixin + (row0 + t) * 2048 + 1024 + g * 512 + 8 * c8); u32x4 w = *ptr;
            w.x = pk2(bflo(w.x) * rs, bfhi(w.x) * rs); w.y = pk2(bflo(w.y) * rs, bfhi(w.y) * rs); w.z = pk2(bflo(w.z) * rs, bfhi(w.z) * rs); w.w = pk2(bflo(w.w) * rs, bfhi(w.w) * rs); *ptr = w; }
        __syncthreads();
    }
}

__device__ __forceinline__ void state_scan(const Params& p, int gt, int GT) {
    for (int e = gt; e < 131072; e += GT) {
        if (e < 65536) {
            const int bh = e >> 12, off4 = e & 4095;
            bf16* st = (bf16*)(p.ws + WS_ST) + (size_t)bh * 128 * 16384 + off4 * 4; const float* dec = (const float*)(p.ws + WS_DEC) + (size_t)bh * 128 * 128 + (off4 & 31) * 4;
            f32x4 S = (f32x4){0.f, 0.f, 0.f, 0.f};
            for (int c0 = 0; c0 < 128; c0 += 8) {
                u32x2 L[8]; f32x4 d[8];
#pragma unroll
                for (int i = 0; i < 8; ++i) { L[i] = *(const u32x2*)(st + (size_t)(c0 + i) * 16384); d[i] = *(const f32x4*)(dec + (c0 + i) * 128); }
#pragma unroll
                for (int i = 0; i < 8; ++i) { *(u32x2*)(st + (size_t)(c0 + i) * 16384) = (u32x2){pk2(S.x, S.y), pk2(S.z, S.w)};
                    S.x = d[i].x * S.x + bflo(L[i].x); S.y = d[i].y * S.y + bfhi(L[i].x); S.z = d[i].z * S.z + bflo(L[i].y); S.w = d[i].w * S.w + bfhi(L[i].y); }
            }
        } else {
            const int e2 = e - 65536, bhd = e2 >> 11, off4 = e2 & 2047;
            bf16* st = (bf16*)(p.ws + WS_ST_S) + (size_t)bhd * 64 * 8192 + off4 * 4; const float* dec = (const float*)(p.ws + WS_DEC_S) + bhd * 64;
            f32x4 S = (f32x4){0.f, 0.f, 0.f, 0.f};
            for (int c0 = 0; c0 < 64; c0 += 8) {
                u32x2 L[8]; float d[8];
#pragma unroll
                for (int i = 0; i < 8; ++i) { L[i] = *(const u32x2*)(st + (size_t)(c0 + i) * 8192); d[i] = dec[c0 + i]; }
#pragma unroll
                for (int i = 0; i < 8; ++i) { *(u32x2*)(st + (size_t)(c0 + i) * 8192) = (u32x2){pk2(S.x, S.y), pk2(S.z, S.w)};
                    S.x = d[i] * S.x + bflo(L[i].x); S.y = d[i] * S.y + bfhi(L[i].x); S.z = d[i] * S.z + bflo(L[i].y); S.w = d[i] * S.w + bfhi(L[i].y); }
            }
        }
    }
}

#ifndef MIX_MODE
#define MIX_MODE 1
#endif
__global__ void __launch_bounds__(512) fwd_kernel(Params p) {
    extern __shared__ __attribute__((aligned(16))) unsigned char lds_raw[];
    LAS unsigned char* lds = (LAS unsigned char*)lds_raw;
    cg::grid_group grid = cg::this_grid();
    volatile LAS unsigned* bst = (volatile LAS unsigned*)(lds + LDS_BYTES - 64);
    if (threadIdx.x < 2) bst[threadIdx.x] = 0u;
    __syncthreads();
    const XcdBarrier xbar = xcd_barrier_post((unsigned*)(p.ws + WS_CTL), bst);
#define GSYNC() xcd_barrier(xbar)
    const int tid = threadIdx.x, lane = tid & 63, wave = __builtin_amdgcn_readfirstlane(tid >> 6);
    const int G = gridDim.x, gw = blockIdx.x * 8 + wave, NGW = G * 8;
    bf16* WIN = (bf16*)(p.ws + WS_WIN); bf16* WOUT = (bf16*)(p.ws + WS_WOUT); bf16* WGU = (bf16*)(p.ws + WS_WGU); bf16* WDN = (bf16*)(p.ws + WS_WDN);
    bf16* XN = (bf16*)(p.ws + WS_XN); bf16* PROJ = (bf16*)(p.ws + WS_PROJ); bf16* HID = (bf16*)(p.ws + WS_PROJ); bf16* MIXO = (bf16*)(p.ws + WS_ST); bf16* FF = (bf16*)(p.ws + WS_ST);

    {
        LAS float* scr = (LAS float*)(lds + wave * 16384);
        constexpr int I_IN = 32 * (NINP / 32), I_OUT = 32 * (D / 32), I_G = 32 * (DFF / 32), I_DN = (DFF / 64) * (D / 32);
        constexpr int NITEMS = I_IN + I_OUT + 2 * I_G + I_DN;
        for (int it = gw; it < NITEMS; it += NGW) {
            int r = it;
            if (r < I_IN) { const int nb = NINP / 32, kb = r / nb, n0 = 32 * (r % nb); transpose_item(p.w_in, D, NIN, WIN, 64 * kb, n0, n0, scr, lane); continue; } r -= I_IN;
            if (r < I_OUT) { const int nb = D / 32, kb = r / nb, n0 = 32 * (r % nb); transpose_item(p.w_out, D, D, WOUT, 64 * kb, n0, n0, scr, lane); continue; } r -= I_OUT;
            if (r < I_G) { const int nb = DFF / 32, kb = r / nb, n0 = 32 * (r % nb); transpose_item(p.w_gate, D, DFF, WGU, 64 * kb, n0, 256 * (n0 >> 7) + (n0 & 127), scr, lane); continue; } r -= I_G;
            if (r < I_G) { const int nb = DFF / 32, kb = r / nb, n0 = 32 * (r % nb); transpose_item(p.w_up, D, DFF, WGU, 64 * kb, n0, 256 * (n0 >> 7) + 128 + (n0 & 127), scr, lane); continue; } r -= I_G;
            { const int nb = D / 32, kb = r / nb, n0 = 32 * (r % nb); transpose_item(p.w_down, DFF, D, WDN, 64 * kb, n0, n0, scr, lane); }
        }
        for (int m = gw; m < M; m += NGW) rms_row_to_bf16(p.x + (size_t)m * D, p.pre_mix_w, XN + (size_t)m * D, lane);
    }
    grid.sync();
    {
        pg8::Gemm g{XN, WIN, M, NINP, D}; pg8::StaticOrder S; S.init(M, NINP, G, (int)blockIdx.x); pg8::EpiBf16 E{PROJ, NINP};
        pg8::gemm_phase<pg8::EpiBf16, pg8::StaticOrder, true, true>(lds, g, S, E);
    }
    GSYNC();
    if (MIX_MODE != 0) {
        if (MIX_MODE != 3) for (int u = blockIdx.x; u < 256; u += G) ssd_unit<false>(lds, p, u);
        if (MIX_MODE != 2) for (int u = blockIdx.x; u < 2048; u += G) hgrn_unit<false>(lds, p, u);
        GSYNC();
        state_scan(p, (int)blockIdx.x * 512 + tid, G * 512);
        GSYNC();
        if (MIX_MODE != 3) for (int u = blockIdx.x; u < 256; u += G) ssd_unit<true>(lds, p, u);
        if (MIX_MODE != 2) for (int u = blockIdx.x; u < 2048; u += G) hgrn_unit<true>(lds, p, u);
    }
    if (MIX_MODE == 0 || MIX_MODE == 3) { if (blockIdx.x < 16) naive_hgrn(lds, p, (int)blockIdx.x); }
    if (MIX_MODE == 0 || MIX_MODE == 2) { if (blockIdx.x >= 16 && blockIdx.x < 20) naive_ssd(lds, p, (int)blockIdx.x - 16); }
    GSYNC();
    {
        pg8::Gemm g{XN, WOUT, M, D, D}; pg8::StaticOrder S; S.init(M, D, G, (int)blockIdx.x); pg8::EpiBf16 E{MIXO, D};
        pg8::gemm_phase<pg8::EpiBf16, pg8::StaticOrder, true, true>(lds, g, S, E);
    }
    GSYNC();
    for (int m = gw; m < M; m += NGW) {
        const float* xr = p.x + (size_t)m * D; const bf16* mr = MIXO + (size_t)m * D; float* orow = p.out + (size_t)m * D; bf16* xn = XN + (size_t)m * D;
        u32x4 mw[4]; float ss = 0.f;
#pragma unroll
        for (int j = 0; j < 4; ++j) { mw[j] = *(const u32x4*)(mr + 8 * (lane + 64 * j));
            const float a0 = bflo(mw[j].x), a1 = bfhi(mw[j].x), a2 = bflo(mw[j].y), a3 = bfhi(mw[j].y), a4 = bflo(mw[j].z), a5 = bfhi(mw[j].z), a6 = bflo(mw[j].w), a7 = bfhi(mw[j].w);
            ss += (a0 * a0 + a1 * a1) + (a2 * a2 + a3 * a3) + (a4 * a4 + a5 * a5) + (a6 * a6 + a7 * a7); }
        const float r1 = rsqrtf(wave_sum(ss) * (1.0f / D) + EPS);
        f32x4 x1[8]; float ss1 = 0.f;
#pragma unroll
        for (int j = 0; j < 4; ++j) { const int base = 8 * (lane + 64 * j);
            const f32x4 xa = *(const f32x4*)(xr + base), xb = *(const f32x4*)(xr + base + 4), wa = *(const f32x4*)(p.post_mix_w + base), wb = *(const f32x4*)(p.post_mix_w + base + 4);
            f32x4 a, b2;
            a.x = xa.x + bflo(mw[j].x) * r1 * wa.x; a.y = xa.y + bfhi(mw[j].x) * r1 * wa.y; a.z = xa.z + bflo(mw[j].y) * r1 * wa.z; a.w = xa.w + bfhi(mw[j].y) * r1 * wa.w;
            b2.x = xb.x + bflo(mw[j].z) * r1 * wb.x; b2.y = xb.y + bfhi(mw[j].z) * r1 * wb.y; b2.z = xb.z + bflo(mw[j].w) * r1 * wb.z; b2.w = xb.w + bfhi(mw[j].w) * r1 * wb.w;
            x1[2 * j] = a; x1[2 * j + 1] = b2; *(f32x4*)(orow + base) = a; *(f32x4*)(orow + base + 4) = b2;
            ss1 += (a.x * a.x + a.y * a.y) + (a.z * a.z + a.w * a.w) + (b2.x * b2.x + b2.y * b2.y) + (b2.z * b2.z + b2.w * b2.w); }
        const float r2 = rsqrtf(wave_sum(ss1) * (1.0f / D) + EPS);
#pragma unroll
        for (int j = 0; j < 4; ++j) { const int base = 8 * (lane + 64 * j); const f32x4 w0 = *(const f32x4*)(p.pre_ffn_w + base), w1 = *(const f32x4*)(p.pre_ffn_w + base + 4); const f32x4 a = x1[2 * j], b2 = x1[2 * j + 1];
            u32x4 o; o.x = pk2(a.x * r2 * w0.x, a.y * r2 * w0.y); o.y = pk2(a.z * r2 * w0.z, a.w * r2 * w0.w); o.z = pk2(b2.x * r2 * w1.x, b2.y * r2 * w1.y); o.w = pk2(b2.z * r2 * w1.z, b2.w * r2 * w1.w);
            *(u32x4*)(xn + base) = o; }
    }
    GSYNC();
    {
        pg8::Gemm g{XN, WGU, M, NGU, D}; pg8::StaticOrder S; S.init(M, NGU, G, (int)blockIdx.x); pg8::EpiSwiglu E{HID, DFF};
        pg8::gemm_phase<pg8::EpiSwiglu, pg8::StaticOrder, true, true>(lds, g, S, E);
    }
    GSYNC();
    {
        pg8::Gemm g{HID, WDN, M, D, DFF}; pg8::StaticOrder S; S.init(M, D, G, (int)blockIdx.x); pg8::EpiBf16 E{FF, D};
        pg8::gemm_phase<pg8::EpiBf16, pg8::StaticOrder, true, true>(lds, g, S, E);
    }
    GSYNC();
    for (int m = gw; m < M; m += NGW) {
        const bf16* fr = FF + (size_t)m * D; float* orow = p.out + (size_t)m * D;
        u32x4 mw[4]; float ss = 0.f;
#pragma unroll
        for (int j = 0; j < 4; ++j) { mw[j] = *(const u32x4*)(fr + 8 * (lane + 64 * j));
            const float a0 = bflo(mw[j].x), a1 = bfhi(mw[j].x), a2 = bflo(mw[j].y), a3 = bfhi(mw[j].y), a4 = bflo(mw[j].z), a5 = bfhi(mw[j].z), a6 = bflo(mw[j].w), a7 = bfhi(mw[j].w);
            ss += (a0 * a0 + a1 * a1) + (a2 * a2 + a3 * a3) + (a4 * a4 + a5 * a5) + (a6 * a6 + a7 * a7); }
        const float r1 = rsqrtf(wave_sum(ss) * (1.0f / D) + EPS);
#pragma unroll
        for (int j = 0; j < 4; ++j) { const int base = 8 * (lane + 64 * j);
            const f32x4 xa = *(const f32x4*)(orow + base), xb = *(const f32x4*)(orow + base + 4), wa = *(const f32x4*)(p.post_ffn_w + base), wb = *(const f32x4*)(p.post_ffn_w + base + 4);
            f32x4 a, b2;
            a.x = xa.x + bflo(mw[j].x) * r1 * wa.x; a.y = xa.y + bfhi(mw[j].x) * r1 * wa.y; a.z = xa.z + bflo(mw[j].y) * r1 * wa.z; a.w = xa.w + bfhi(mw[j].y) * r1 * wa.w;
            b2.x = xb.x + bflo(mw[j].z) * r1 * wb.x; b2.y = xb.y + bfhi(mw[j].z) * r1 * wb.y; b2.z = xb.z + bflo(mw[j].w) * r1 * wb.z; b2.w = xb.w + bfhi(mw[j].w) * r1 * wb.w;
            *(f32x4*)(orow + base) = a; *(f32x4*)(orow + base + 4) = b2; }
    }
}

extern "C" void kernel_launch(void* const* d_in, const int* in_sizes, int n_in, void* d_out, int out_size, void* d_ws, size_t ws_size, hipStream_t stream) {
    static int grid = 0;
    if (grid == 0) {
        if (n_in != 18 || in_sizes[0] != M * D || out_size != M * D || ws_size < WS_END) { fprintf(stderr, "kernel_launch: unexpected shapes (n_in %d, in0 %d, out %d, ws %zu)\n", n_in, n_in > 0 ? in_sizes[0] : -1, out_size, ws_size); grid = -1; return; }
        int dev = 0, cus = 0, per_cu = 0;
        if (hipGetDevice(&dev) != hipSuccess || hipDeviceGetAttribute(&cus, hipDeviceAttributeMultiprocessorCount, dev) != hipSuccess) { grid = -1; return; }
        if (hipFuncSetAttribute((const void*)fwd_kernel, hipFuncAttributeMaxDynamicSharedMemorySize, LDS_BYTES) != hipSuccess) { fprintf(stderr, "kernel_launch: hipFuncSetAttribute failed\n"); grid = -1; return; }
        if (hipOccupancyMaxActiveBlocksPerMultiprocessor(&per_cu, (const void*)fwd_kernel, 512, LDS_BYTES) != hipSuccess || per_cu < 1) { fprintf(stderr, "kernel_launch: occupancy query says %d\n", per_cu); per_cu = 1; }
        (void)hipGetLastError();
        grid = cus;
    }
    if (grid < 0) return;
    Params p{};
    p.x = (const float*)d_in[0]; p.pre_mix_w = (const float*)d_in[1]; p.w_in = (const float*)d_in[2]; p.lb_logits = (const float*)d_in[3]; p.conv_w = (const float*)d_in[4]; p.conv_b = (const float*)d_in[5];
    p.dt_bias = (const float*)d_in[6]; p.a_log = (const float*)d_in[7]; p.d_skip = (const float*)d_in[8]; p.hgrn_nw = (const float*)d_in[9]; p.ssd_nw = (const float*)d_in[10]; p.w_out = (const float*)d_in[11];
    p.post_mix_w = (const float*)d_in[12]; p.pre_ffn_w = (const float*)d_in[13]; p.w_gate = (const float*)d_in[14]; p.w_up = (const float*)d_in[15]; p.w_down = (const float*)d_in[16]; p.post_ffn_w = (const float*)d_in[17];
    p.out = (float*)d_out; p.ws = (unsigned char*)d_ws;
    if (hipMemsetAsync(d_ws, 0, CTL_ZERO_BYTES, stream) != hipSuccess) { fprintf(stderr, "kernel_launch: memset failed\n"); return; }
    void* args[] = {&p};
    hipError_t e = hipLaunchCooperativeKernel((const void*)fwd_kernel, dim3(grid), dim3(512), args, LDS_BYTES, stream);
    if (e != hipSuccess) fprintf(stderr, "kernel_launch: cooperative launch failed: %s (grid %d)\n", hipGetErrorString(e), grid);
}
```

```cpp
#include <hip/hip_runtime.h>
#include <hip/hip_cooperative_groups.h>
#include <cstdio>
#include <cstdint>
namespace cg = cooperative_groups;
namespace pg8 {
#define PG8_LAS __attribute__((address_space(3)))
typedef unsigned short bf16_t;
typedef short bf16x8 __attribute__((ext_vector_type(8)));
typedef float f32x4 __attribute__((ext_vector_type(4)));
typedef unsigned u32x4 __attribute__((ext_vector_type(4)));
constexpr int BM = 256, BK = 64, HALF = 128, HTB = HALF * BK * 2  , STAGE_BYTES = 8 * HTB, NXCD = 8, WGM = 8;

__host__ __device__ __forceinline__ int lds_byte(int r, int c) { const int st = (r >> 4) * 2 + (c >> 5), rr = r & 15, cc = c & 31, ob = rr * 64 + cc * 2; return st * 1024 + (ob ^ (((ob >> 9) & 1) << 5)); }
__host__ __device__ __forceinline__ void stage_rc(int b, int& R, int& C) { const int st = b / 1024, sb = b % 1024, swz = sb ^ (((sb >> 9) & 1) << 5); R = (st >> 1) * 16 + swz / 64; C = (st & 1) * 32 + (swz % 64) / 2; }
__host__ __device__ __forceinline__ int perm32(int rho) { const int n = rho >> 4, i = rho & 15; return 8 * (i >> 2) + 4 * n + (i & 3); }

struct Unit { int pm, pn; };
struct Gemm { const bf16_t* A; const bf16_t* Bt; int M, N, K; };

struct StaticOrder {
    int nM, nN, nwg, G, c, reps;
    __host__ __device__ void init(int M, int N, int G_, int c_, int reps_ = 1) { nM = M / BM; nN = N / BM; nwg = nM * nN; G = G_; c = c_; reps = reps_; }
    __host__ __device__ bool next(int i, Unit& u) const {
        const long L = (long)i * G + c; if (L >= (long)nwg * reps) return false;
        int wgid = (int)(L % nwg); { const int q = nwg / NXCD, r = nwg % NXCD, xcd = wgid % NXCD, off = wgid / NXCD; wgid = (xcd < r ? xcd * (q + 1) : r * (q + 1) + (xcd - r) * q) + off; }
        const int nig = WGM * nN, gid = wgid / nig, fm = gid * WGM, gsz = (nM - fm) < WGM ? (nM - fm) : WGM;
        u.pm = fm + ((wgid % nig) % gsz); u.pn = (wgid % nig) / gsz; return true;
    }
    __device__ __forceinline__ void a_ready(const Unit&) const {}
    __device__ __forceinline__ void done(const Unit&) const {}
};

__device__ __forceinline__ unsigned cvt_pk_bf16(float lo, float hi) { unsigned r; asm volatile("v_cvt_pk_bf16_f32 %0, %1, %2" : "=v"(r) : "v"(lo), "v"(hi)); return r; }
struct EpiBf16 {
    static constexpr bool PERM = true, AFTER_DRAIN = false;
    bf16_t* O; int ldc;
    __device__ __forceinline__ void operator()(const f32x4 (&acc)[2][2][4][2], const Unit& u, int wr, int wc, int fr, int fq) const {
        const int row0 = u.pm * BM + wr * 64 + fr; const int col0 = u.pn * BM + wc * 32 + 8 * fq;
#pragma unroll
        for (int ai = 0; ai < 2; ++ai)
#pragma unroll
            for (int m = 0; m < 4; ++m) { bf16_t* rowp = O + (size_t)(row0 + ai * HALF + m * 16) * ldc + col0;
#pragma unroll
                for (int bj = 0; bj < 2; ++bj) { const f32x4 v0 = acc[ai][bj][m][0], v1 = acc[ai][bj][m][1];
                    u32x4 w; w.x = cvt_pk_bf16(v0[0], v0[1]); w.y = cvt_pk_bf16(v0[2], v0[3]); w.z = cvt_pk_bf16(v1[0], v1[1]); w.w = cvt_pk_bf16(v1[2], v1[3]);
                    *(u32x4*)(rowp + bj * HALF) = w; } }
    }
};
__device__ __forceinline__ float silu_f(float v) { return v / (1.0f + __expf(-v)); }
struct EpiSwiglu {
    static constexpr bool PERM = true, AFTER_DRAIN = false;
    bf16_t* O; int ldc;
    __device__ __forceinline__ void operator()(const f32x4 (&acc)[2][2][4][2], const Unit& u, int wr, int wc, int fr, int fq) const {
        const int row0 = u.pm * BM + wr * 64 + fr; const int col0 = u.pn * HALF + wc * 32 + 8 * fq;
#pragma unroll
        for (int ai = 0; ai < 2; ++ai)
#pragma unroll
            for (int m = 0; m < 4; ++m) { bf16_t* rowp = O + (size_t)(row0 + ai * HALF + m * 16) * ldc + col0;
                const f32x4 g0 = acc[ai][0][m][0], g1 = acc[ai][0][m][1], u0 = acc[ai][1][m][0], u1 = acc[ai][1][m][1];
                u32x4 w; w.x = cvt_pk_bf16(silu_f(g0[0]) * u0[0], silu_f(g0[1]) * u0[1]); w.y = cvt_pk_bf16(silu_f(g0[2]) * u0[2], silu_f(g0[3]) * u0[3]);
                w.z = cvt_pk_bf16(silu_f(g1[0]) * u1[0], silu_f(g1[1]) * u1[1]); w.w = cvt_pk_bf16(silu_f(g1[2]) * u1[2], silu_f(g1[3]) * u1[3]);
                *(u32x4*)rowp = w; }
    }
};

struct EpiProj {
    static constexpr bool PERM = true, AFTER_DRAIN = false;
    bf16_t* O; int ldc; const float* lbv; const float* dtb;
    template <int MODE> __device__ __forceinline__ static float tf(float v, float a) {
        if (MODE == 1) return silu_f(v) * 0.08838834764831845f;
        if (MODE == 2) return __logf(a + (1.0f - a) * __builtin_amdgcn_rcpf(1.0f + __expf(-v)));
        if (MODE == 3) return silu_f(v);
        if (MODE == 4) { const float x = v + a; return x > 20.f ? x : __logf(1.0f + __expf(x)); }
        return v;
    }
    template <int MODE> __device__ __forceinline__ void run(const f32x4 (&acc)[2][2][4][2], const Unit& u, int wr, int wc, int fr, int fq) const {
        const int row0 = u.pm * BM + wr * 64 + fr; const int col0 = u.pn * BM + wc * 32 + 8 * fq;
#pragma unroll
        for (int bj = 0; bj < 2; ++bj) {
            f32x4 a0 = (f32x4){0.f, 0.f, 0.f, 0.f}, a1 = (f32x4){0.f, 0.f, 0.f, 0.f};
            if (MODE == 2) { a0 = *(const f32x4*)(lbv + col0 + bj * HALF - 1024); a1 = *(const f32x4*)(lbv + col0 + bj * HALF - 1024 + 4); }
            if (MODE == 4) { if (col0 + bj * HALF < 6672) { a0 = *(const f32x4*)(dtb + col0 + bj * HALF - 6656); a1 = *(const f32x4*)(dtb + col0 + bj * HALF - 6656 + 4); } }
#pragma unroll
            for (int ai = 0; ai < 2; ++ai)
#pragma unroll
                for (int m = 0; m < 4; ++m) { bf16_t* rowp = O + (size_t)(row0 + ai * HALF + m * 16) * ldc + col0 + bj * HALF;
                    const f32x4 v0 = acc[ai][bj][m][0], v1 = acc[ai][bj][m][1];
                    u32x4 w; w.x = cvt_pk_bf16(tf<MODE>(v0[0], a0[0]), tf<MODE>(v0[1], a0[1])); w.y = cvt_pk_bf16(tf<MODE>(v0[2], a0[2]), tf<MODE>(v0[3], a0[3]));
                    w.z = cvt_pk_bf16(tf<MODE>(v1[0], a1[0]), tf<MODE>(v1[1], a1[1])); w.w = cvt_pk_bf16(tf<MODE>(v1[2], a1[2]), tf<MODE>(v1[3], a1[3]));
                    *(u32x4*)rowp = w; }
        }
    }
    __device__ __forceinline__ void operator()(const f32x4 (&acc)[2][2][4][2], const Unit& u, int wr, int wc, int fr, int fq) const {
        const int pn = u.pn;
        if (pn < 4) run<1>(acc, u, wr, wc, fr, fq);
        else if (pn < 8) run<2>(acc, u, wr, wc, fr, fq);
        else if (pn >= 12 && pn < 20) run<3>(acc, u, wr, wc, fr, fq);
        else if (pn == 26) run<4>(acc, u, wr, wc, fr, fq);
        else run<0>(acc, u, wr, wc, fr, fq);
    }
};

template <class Epi, class Sched, bool ALIGN_EPI = false, bool SP2 = false>
__device__ __forceinline__ void gemm_phase(PG8_LAS unsigned char* lds, const Gemm g, const Sched& S, const Epi& E) {
    int tid_ = threadIdx.x; asm volatile("" : "+v"(tid_));
    const int tid = tid_, wid = __builtin_amdgcn_readfirstlane(tid >> 6), lane = tid & 63, wr = wid >> 2, wc = wid & 3, fr = lane & 15, fq = lane >> 4;
    const int K = g.K, nt = K / BK;
    unsigned voffA[2], voffB[2];
#pragma unroll
    for (int i = 0; i < 2; ++i) { int R, C; stage_rc(tid * 16 + i * 8192, R, C); const int Rb = Epi::PERM ? ((R & ~31) + perm32(R & 31)) : R;
        voffA[i] = (unsigned)(R * K + C) * 2u; voffB[i] = (unsigned)(Rb * K + C) * 2u; }
    const size_t kstep = (size_t)(BK * 2);
    const size_t hstep = (size_t)HALF * K * 2;
    const size_t tstep = 2 * hstep;
    const unsigned ldsw = (unsigned)wid * 1024u;
    const int aoff = lds_byte(wr * 64 + fr, fq * 8), boff = lds_byte(wc * 32 + fr, fq * 8);
#define PG8_SA(b, h) (((b) * 2 + (h)) * HTB)
#define PG8_SB(b, h) ((4 + (b) * 2 + (h)) * HTB)
#define PG8_STAGE(bufoff, gbase, voff) do { _Pragma("unroll") for (int _i = 0; _i < 2; ++_i) \
        __builtin_amdgcn_global_load_lds((const unsigned*)((const char*)(gbase) + (voff)[_i]), (PG8_LAS unsigned*)(lds + (bufoff) + ldsw + _i * 8192), 16, 0, 0); } while (0)
#define PG8_LDA(dst, b, h) do { _Pragma("unroll") for (int m = 0; m < 4; ++m) _Pragma("unroll") for (int k = 0; k < 2; ++k) dst[m][k] = *(const PG8_LAS bf16x8*)(lds + PG8_SA(b, h) + aoff + m * 2048 + k * 1024); } while (0)
#define PG8_LDB(dst, b, h) do { _Pragma("unroll") for (int n = 0; n < 2; ++n) _Pragma("unroll") for (int k = 0; k < 2; ++k) dst[n][k] = *(const PG8_LAS bf16x8*)(lds + PG8_SB(b, h) + boff + n * 2048 + k * 1024); } while (0)
#define PG8_MMA(ai, bj, At, Bt) do { __builtin_amdgcn_s_setprio(1); _Pragma("unroll") for (int m = 0; m < 4; ++m) _Pragma("unroll") for (int n = 0; n < 2; ++n) _Pragma("unroll") for (int k = 0; k < 2; ++k) \
        acc[ai][bj][m][n] = __builtin_amdgcn_mfma_f32_16x16x32_bf16(Bt[n][k], At[m][k], acc[ai][bj][m][n], 0, 0, 0); __builtin_amdgcn_s_setprio(0); } while (0)
#define PG8_WAIT_V(n) asm volatile("s_waitcnt vmcnt(" #n ")" ::: "memory")
#define PG8_WAIT_L(n) asm volatile("s_waitcnt lgkmcnt(" #n ")" ::: "memory")
#define PG8_BAR __builtin_amdgcn_s_barrier()
#define PG8_SCHED __builtin_amdgcn_sched_barrier(0)
    Unit cur, nxt; int ui = 0;
    if (!S.next(0, cur)) return;
    f32x4 acc[2][2][4][2];
#pragma unroll
    for (int a = 0; a < 2; ++a)
#pragma unroll
        for (int b = 0; b < 2; ++b)
#pragma unroll
            for (int m = 0; m < 4; ++m)
#pragma unroll
                for (int n = 0; n < 2; ++n) acc[a][b][m][n] = (f32x4){0.f, 0.f, 0.f, 0.f};
    bf16x8 At[4][2], B0[2][2], B1[2][2];
    const char* cA = (const char*)g.A + (size_t)cur.pm * tstep; const char* cB = (const char*)g.Bt + (size_t)cur.pn * tstep;
    S.a_ready(cur);
    if constexpr (SP2) {
        PG8_STAGE(PG8_SB(0, 0), cB, voffB); PG8_STAGE(PG8_SB(0, 1), cB + hstep, voffB); PG8_STAGE(PG8_SA(0, 0), cA, voffA); PG8_STAGE(PG8_SA(0, 1), cA + hstep, voffA);
        if (wr == 1) PG8_BAR;
        PG8_WAIT_V(2); PG8_BAR;
        PG8_STAGE(PG8_SB(1, 0), cB + kstep, voffB); PG8_STAGE(PG8_SA(1, 0), cA + kstep, voffA); PG8_STAGE(PG8_SB(1, 1), cB + hstep + kstep, voffB);
        PG8_WAIT_V(6); PG8_BAR;
    } else {
        PG8_STAGE(PG8_SB(0, 0), cB, voffB); PG8_STAGE(PG8_SA(0, 0), cA, voffA); PG8_STAGE(PG8_SB(0, 1), cB + hstep, voffB); PG8_STAGE(PG8_SA(0, 1), cA + hstep, voffA);
        if (wr == 1) PG8_BAR;
        PG8_WAIT_V(4); PG8_BAR;
        PG8_STAGE(PG8_SB(1, 0), cB + kstep, voffB); PG8_STAGE(PG8_SA(1, 0), cA + kstep, voffA); PG8_STAGE(PG8_SB(1, 1), cB + hstep + kstep, voffB);
        PG8_WAIT_V(6); PG8_BAR;
    }
    for (;;) {
        const bool has_next = S.next(ui + 1, nxt);
        const char* nA = has_next ? (const char*)g.A + (size_t)nxt.pm * tstep : cA; const char* nB = has_next ? (const char*)g.Bt + (size_t)nxt.pn * tstep : cB;
        for (int t = 0; t < nt; t += 2) {
            const bool last = (t == nt - 2);
            const char* a1 = cA + (size_t)(t + 1) * kstep;
            const char* a2 = last ? nA : cA + (size_t)(t + 2) * kstep; const char* b2 = last ? nB : cB + (size_t)(t + 2) * kstep;
            const char* a3 = a2 + kstep; const char* b3 = b2 + kstep;
            if (last && has_next) S.a_ready(nxt);
            if constexpr (SP2) {
            PG8_LDB(B0, 0, 0); PG8_LDB(B1, 0, 1); PG8_SCHED; PG8_LDA(At, 0, 0); PG8_STAGE(PG8_SA(1, 1), a1 + hstep, voffA);
            PG8_WAIT_V(8); PG8_WAIT_L(0); PG8_BAR; PG8_MMA(0, 0, At, B0); PG8_MMA(0, 1, At, B1); PG8_BAR; PG8_SCHED;
            PG8_LDA(At, 0, 1); PG8_STAGE(PG8_SB(0, 0), b2, voffB); PG8_STAGE(PG8_SB(0, 1), b2 + hstep, voffB); PG8_STAGE(PG8_SA(0, 0), a2, voffA);
            PG8_WAIT_V(8); PG8_WAIT_L(0); PG8_BAR; PG8_MMA(1, 0, At, B0); PG8_MMA(1, 1, At, B1); PG8_BAR; PG8_SCHED;
            PG8_LDB(B0, 1, 0); PG8_LDB(B1, 1, 1); PG8_SCHED; PG8_LDA(At, 1, 0); PG8_STAGE(PG8_SA(0, 1), a2 + hstep, voffA);
            PG8_WAIT_V(8); PG8_WAIT_L(0); PG8_BAR; PG8_MMA(0, 0, At, B0); PG8_MMA(0, 1, At, B1); PG8_BAR; PG8_SCHED;
            PG8_LDA(At, 1, 1); PG8_STAGE(PG8_SB(1, 0), b3, voffB); PG8_STAGE(PG8_SB(1, 1), b3 + hstep, voffB); PG8_STAGE(PG8_SA(1, 0), a3, voffA);
            PG8_WAIT_V(8); PG8_WAIT_L(0); PG8_BAR; PG8_MMA(1, 0, At, B0); PG8_MMA(1, 1, At, B1); PG8_BAR; PG8_SCHED;
            } else {
            PG8_LDB(B0, 0, 0); PG8_SCHED; PG8_LDA(At, 0, 0); PG8_STAGE(PG8_SA(1, 1), a1 + hstep, voffA);
            PG8_WAIT_L(8); PG8_BAR; PG8_WAIT_L(0); PG8_MMA(0, 0, At, B0); PG8_BAR; PG8_SCHED;
            PG8_LDB(B1, 0, 1); PG8_STAGE(PG8_SB(0, 0), b2, voffB);
            PG8_BAR; PG8_WAIT_L(0); PG8_MMA(0, 1, At, B1); PG8_BAR;
            PG8_LDA(At, 0, 1); PG8_STAGE(PG8_SA(0, 0), a2, voffA);
            PG8_BAR; PG8_WAIT_L(0); PG8_MMA(1, 0, At, B0); PG8_BAR; PG8_SCHED;
            PG8_STAGE(PG8_SB(0, 1), b2 + hstep, voffB);
            PG8_WAIT_V(6); PG8_BAR; PG8_MMA(1, 1, At, B1); PG8_BAR;
            PG8_LDB(B0, 1, 0); PG8_SCHED; PG8_LDA(At, 1, 0); PG8_STAGE(PG8_SA(0, 1), a2 + hstep, voffA);
            PG8_WAIT_L(8); PG8_BAR; PG8_WAIT_L(0); PG8_MMA(0, 0, At, B0); PG8_BAR; PG8_SCHED;
            PG8_LDB(B1, 1, 1); PG8_STAGE(PG8_SB(1, 0), b3, voffB);
            PG8_BAR; PG8_WAIT_L(0); PG8_MMA(0, 1, At, B1); PG8_BAR;
            PG8_LDA(At, 1, 1); PG8_STAGE(PG8_SA(1, 0), a3, voffA);
            PG8_BAR; PG8_WAIT_L(0); PG8_MMA(1, 0, At, B0); PG8_BAR; PG8_SCHED;
            PG8_STAGE(PG8_SB(1, 1), b3 + hstep, voffB);
            PG8_WAIT_V(6); PG8_BAR; PG8_MMA(1, 1, At, B1); PG8_BAR;
            }
        }
        if constexpr (ALIGN_EPI) { if (wr == 0) PG8_BAR; }
        if constexpr (!Epi::AFTER_DRAIN) { E(acc, cur, wr, wc, fr, fq); S.done(cur); }
        if (!has_next) break;
#pragma unroll
        for (int a = 0; a < 2; ++a)
#pragma unroll
            for (int b = 0; b < 2; ++b)
#pragma unroll
                for (int m = 0; m < 4; ++m)
#pragma unroll
                    for (int n = 0; n < 2; ++n) acc[a][b][m][n] = (f32x4){0.f, 0.f, 0.f, 0.f};
        cur = nxt; cA = nA; cB = nB; ++ui;
        if constexpr (ALIGN_EPI) { if (wr == 1) PG8_BAR; }
    }
    PG8_WAIT_V(0);
    if constexpr (!ALIGN_EPI) { if (wr == 0) PG8_BAR; }
    PG8_BAR;
    if constexpr (Epi::AFTER_DRAIN) { E.fused(acc, cur, wr, wc, fr, fq, lds, wid, lane); S.done(cur); }
#undef PG8_SA
#undef PG8_SB
#undef PG8_STAGE
#undef PG8_LDA
#undef PG8_LDB
#undef PG8_MMA
#undef PG8_WAIT_V
#undef PG8_WAIT_L
#undef PG8_BAR
#undef PG8_SCHED
}
}

constexpr int BATCH = 2, SEQ = 8192, M = BATCH * SEQ, D = 2048;
constexpr int NIN = 6672, NINP = 6912, DFF = 5632, NGU = 2 * DFF;
constexpr int C_Q = 0, C_F = 1024, C_I = 2048, C_G = 3072, C_Z = 4096, C_XBC = 5120, C_DT = 6656;
constexpr int XBC_W = 1536;
constexpr float EPS = 1e-6f;
constexpr size_t MiB = 1u << 20;
constexpr size_t WS_CTL = 0, CTL_ZERO_BYTES = 65536;
constexpr size_t WS_LB = 65536;
constexpr size_t WS_WIN = 1 * MiB;
constexpr size_t WS_WOUT = 28 * MiB;
constexpr size_t WS_WGU = 36 * MiB;
constexpr size_t WS_WDN = 80 * MiB;
constexpr size_t WS_XN = 102 * MiB;
constexpr size_t WS_PROJ = 166 * MiB;
constexpr size_t WS_ST = 382 * MiB;
constexpr size_t WS_DEC = 478 * MiB;
constexpr size_t WS_END = 480 * MiB;
constexpr int LDS_BYTES = 147456;

#define LAS __attribute__((address_space(3)))
typedef unsigned short bf16;
typedef float f32x4 __attribute__((ext_vector_type(4)));
typedef unsigned u32x4 __attribute__((ext_vector_type(4)));
#define LDS_WAIT() asm volatile("s_waitcnt lgkmcnt(0)" ::: "memory")
__device__ __forceinline__ float bf2f(unsigned short u) { return __uint_as_float(((unsigned)u) << 16); }
__device__ __forceinline__ unsigned f2bf(float f) { unsigned u = __float_as_uint(f); return (u + 0x7fffu + ((u >> 16) & 1u)) >> 16; }
__device__ __forceinline__ unsigned pk2(float lo, float hi) { return f2bf(lo) | (f2bf(hi) << 16); }
__device__ __forceinline__ float bflo(unsigned w) { return __uint_as_float(w << 16); }
__device__ __forceinline__ float bfhi(unsigned w) { return __uint_as_float(w & 0xffff0000u); }
__device__ __forceinline__ float wave_sum(float v) {
#pragma unroll
    for (int o = 1; o < 64; o <<= 1) v += __shfl_xor(v, o);
    return v;
}
__device__ __forceinline__ float sigm(float x) { return 1.0f / (1.0f + __expf(-x)); }
__device__ __forceinline__ float silu(float x) { return x / (1.0f + __expf(-x)); }

struct Params {
    const float *x, *pre_mix_w, *w_in, *lb_logits, *conv_w, *conv_b, *dt_bias, *a_log, *d_skip, *hgrn_nw, *ssd_nw, *w_out, *post_mix_w, *pre_ffn_w, *w_gate, *w_up, *w_down, *post_ffn_w;
    float* out; unsigned char* ws;
};

__device__ __forceinline__ void transpose_item(const float* W, int K, int N, bf16* WT, int k0, int n0, int rowb, LAS float* scr, int lane) {
    const int n_in = n0 + (lane & 31);
#pragma unroll 8
    for (int i = 0; i < 32; ++i) { const int kk = 2 * i + (lane >> 5); scr[kk * 33 + (lane & 31)] = (n_in < N) ? W[(size_t)(k0 + kk) * N + n_in] : 0.f; }
    LDS_WAIT();
    const int c = lane & 7;
#pragma unroll
    for (int j = 0; j < 4; ++j) { const int n = (lane >> 3) + 8 * j; const LAS float* s = scr + (8 * c) * 33 + n;
        u32x4 o; o.x = pk2(s[0 * 33], s[1 * 33]); o.y = pk2(s[2 * 33], s[3 * 33]); o.z = pk2(s[4 * 33], s[5 * 33]); o.w = pk2(s[6 * 33], s[7 * 33]);
        *(u32x4*)(WT + (size_t)(rowb + n) * K + k0 + 8 * c) = o; }
    LDS_WAIT();
}
__device__ __forceinline__ void rms_row_to_bf16(const float* xrow, const float* w, bf16* orow, int lane) {
    f32x4 v[8]; float ss = 0.f;
#pragma unroll
    for (int j = 0; j < 4; ++j) { const int base = 8 * (lane + 64 * j); v[2 * j] = *(const f32x4*)(xrow + base); v[2 * j + 1] = *(const f32x4*)(xrow + base + 4);
        const f32x4 a = v[2 * j], b = v[2 * j + 1]; ss += (a.x * a.x + a.y * a.y) + (a.z * a.z + a.w * a.w) + (b.x * b.x + b.y * b.y) + (b.z * b.z + b.w * b.w); }
    const float r = rsqrtf(wave_sum(ss) * (1.0f / D) + EPS);
#pragma unroll
    for (int j = 0; j < 4; ++j) { const int base = 8 * (lane + 64 * j); const f32x4 w0 = *(const f32x4*)(w + base), w1 = *(const f32x4*)(w + base + 4); const f32x4 a = v[2 * j], b = v[2 * j + 1];
        u32x4 o; o.x = pk2(a.x * r * w0.x, a.y * r * w0.y); o.y = pk2(a.z * r * w0.z, a.w * r * w0.w); o.z = pk2(b.x * r * w1.x, b.y * r * w1.y); o.w = pk2(b.z * r * w1.z, b.w * r * w1.w);
        *(u32x4*)(orow + base) = o; }
}

#define XB_TMO      128
#define XB_XCNT(j)  (256  + 64 * (j))
#define XB_XSUB(j)  (1280 + 64 * (j))
#define XB_XGEN(j)  (2304 + 64 * (j))
#define XB_TOP      3328
#define XB_TOPGEN   3392
#define XCD_BAR_WORDS 3456
#define XB_SPIN_CAP (1u << 18)

__device__ __forceinline__ unsigned xb_ld(unsigned* p)              { return __hip_atomic_load(p, __ATOMIC_RELAXED, __HIP_MEMORY_SCOPE_AGENT); }
__device__ __forceinline__ unsigned xb_add(unsigned* p, unsigned v) { return __hip_atomic_fetch_add(p, v, __ATOMIC_RELAXED, __HIP_MEMORY_SCOPE_AGENT); }
__device__ __forceinline__ unsigned xb_xcc_id() { return (unsigned)__builtin_amdgcn_s_getreg((3 << 11) | 20) & 0xFu; }
#define XB_SPIN(cond, bar) do { unsigned _sp = 0; while (cond) { __builtin_amdgcn_s_sleep(1); \
    if ((++_sp & 255u) == 0u) { if (xb_ld(&(bar)[XB_TMO])) break; if (_sp > XB_SPIN_CAP) { atomicAdd(&(bar)[XB_TMO], 1u); break; } } } } while (0)

struct XcdBarrier {
    unsigned* bar; unsigned x;
    volatile LAS unsigned* st;
};

__device__ __forceinline__ XcdBarrier xcd_barrier_post(unsigned* bar, volatile LAS unsigned* st) {
    XcdBarrier b; b.bar = bar; b.x = xb_xcc_id(); b.st = st;
    if (threadIdx.x == 0) (void)xb_add(&bar[XB_XCNT(b.x)], 1u);
    return b;
}
__device__ __forceinline__ void xcd_barrier_complete(unsigned* bar, unsigned x, unsigned& nloc, unsigned& nx) {
    const unsigned G = gridDim.x * gridDim.y * gridDim.z;
    unsigned sum, cnt, mine, sp = 0u;
    for (;;) {
        sum = 0u; cnt = 0u; mine = 0u;
#pragma unroll
        for (unsigned j = 0; j < 16; ++j) { const unsigned c = xb_ld(&bar[XB_XCNT(j)]); sum += c; cnt += (c > 0u) ? 1u : 0u; mine = (j == x) ? c : mine; }
        if (sum == G) break;
        __builtin_amdgcn_s_sleep(1);
        if ((++sp & 255u) == 0u) { if (xb_ld(&bar[XB_TMO])) break; if (sp > XB_SPIN_CAP) { atomicAdd(&bar[XB_TMO], 1u); break; } }
    }
    nloc = mine > 0u ? mine : 1u; nx = cnt > 0u ? cnt : 1u;
}

__device__ __forceinline__ void xcd_barrier(const XcdBarrier& b) {
    asm volatile("s_waitcnt vmcnt(0)" ::: "memory");
    __syncthreads();
    if (threadIdx.x == 0) {
        unsigned* bar = b.bar;
        __builtin_amdgcn_s_waitcnt(0);
        unsigned nloc = b.st[0], nx = b.st[1];
        if (nloc == 0u) { xcd_barrier_complete(bar, b.x, nloc, nx); b.st[0] = nloc; b.st[1] = nx; }
        const unsigned old = xb_add(&bar[XB_XSUB(b.x)], 1u);
        const unsigned gen = old / nloc;
        if (old + 1u == (gen + 1u) * nloc) {
            __builtin_amdgcn_fence(__ATOMIC_RELEASE, "agent");
            asm volatile("s_waitcnt vmcnt(0)" ::: "memory");
            const unsigned og = xb_add(&bar[XB_TOP], 1u);
            const unsigned tg = og / nx;
            if (og + 1u == (tg + 1u) * nx) xb_add(&bar[XB_TOPGEN], 1u);
            else XB_SPIN(xb_ld(&bar[XB_TOPGEN]) == tg, bar);
            __builtin_amdgcn_fence(__ATOMIC_ACQUIRE, "agent");
            xb_add(&bar[XB_XGEN(b.x)], 1u);
            asm volatile("s_waitcnt vmcnt(0)" ::: "memory");
        } else {
            XB_SPIN(xb_ld(&bar[XB_XGEN(b.x)]) == gen, bar);
            __builtin_amdgcn_fence(__ATOMIC_ACQUIRE, "agent");
            asm volatile("s_waitcnt vmcnt(0)" ::: "memory");
        }
    }
    __syncthreads();
}
constexpr size_t WS_ST_S = WS_ST + 64 * MiB;
constexpr size_t WS_DEC_S = WS_DEC + 1 * MiB;
typedef short bf16x8 __attribute__((ext_vector_type(8)));
typedef unsigned u32x2 __attribute__((ext_vector_type(2)));
#define LBAR() do { asm volatile("s_waitcnt lgkmcnt(0)" ::: "memory"); __builtin_amdgcn_s_barrier(); asm volatile("" ::: "memory"); } while (0)
#define G16(base, eoff) (*(const u32x4*)((const bf16*)(base) + (unsigned)(eoff)))
#define G2(base, eoff) (((const bf16*)(base))[(unsigned)(eoff)])
__device__ __forceinline__ f32x4 mma_lds(const LAS bf16* A, int lda, const LAS bf16* Bt, int ldb, int K, f32x4 acc, int lane) {
    const int r = lane & 15, q = lane >> 4;
    for (int k0 = 0; k0 < K; k0 += 32) {
        const bf16x8 a = *(const LAS bf16x8*)(A + r * lda + k0 + 8 * q);
        const bf16x8 b = *(const LAS bf16x8*)(Bt + r * ldb + k0 + 8 * q);
        acc = __builtin_amdgcn_mfma_f32_16x16x32_bf16(a, b, acc, 0, 0, 0);
    }
    return acc;
}

template <bool OUT>
__device__ __forceinline__ void hgrn_unit(LAS unsigned char* lds, const Params& p, int u) {
    const int tid = threadIdx.x, lane = tid & 63, wave = __builtin_amdgcn_readfirstlane(tid >> 6), I = wave >> 1, k = tid & 127, r = lane & 15, q = lane >> 4;
    const int b = u >> 10, c = (u >> 3) & 127, h = u & 7;
    const unsigned row0 = (unsigned)(b * SEQ + c * 64), rowb = row0 * NINP;
    const bf16* proj = (const bf16*)(p.ws + WS_PROJ);
    const int uh = (b * 8 + h) * 128 + c;
    bf16* STb = (bf16*)(p.ws + WS_ST); const unsigned so = (unsigned)uh * 16384u;
    LAS float* Tsum = (LAS float*)lds;
    LAS bf16* vT = (LAS bf16*)(lds + 2048);
    LAS bf16* KdT = (LAS bf16*)(lds + 20480);
    LAS bf16* Qt = (LAS bf16*)(lds + 20480);
    LAS bf16* Qb = Qt + 64 * 136;
    LAS bf16* KT = Qb + 64 * 136;
    LAS bf16* P = KT + 160 * 136;
    LAS float* red = (LAS float*)(P + 64 * 72);
    LAS bf16* Sl = (LAS bf16*)(lds + 108544);
    const int rt = wave >> 1;
    u32x4 Sreg[4]; unsigned short greg[16];
    if (OUT) {
#pragma unroll
        for (int i = 0; i < 4; ++i) { const int e = tid + 512 * i; Sreg[i] = G16(STb, so + (e >> 4) * 128 + 8 * (e & 15)); }
#pragma unroll
        for (int j = 0; j < 4; ++j)
#pragma unroll
            for (int c4 = 0; c4 < 4; ++c4) greg[j * 4 + c4] = G2(proj, rowb + (16 * rt + 4 * q + j) * NINP + C_G + h * 128 + 16 * (4 * (wave & 1) + c4) + r);
    }
    float bl[16], kk[16], qv[16];
    {
        const unsigned po = rowb + 16 * I * NINP + h * 128 + k; float run = 0.f;
        unsigned short fraw[16], qraw[16];
#pragma unroll
        for (int j = 0; j < 16; ++j) { fraw[j] = G2(proj, po + j * NINP + C_F); qraw[j] = OUT ? G2(proj, po + j * NINP + C_Q) : (unsigned short)0; }
        unsigned w[8];
#pragma unroll
        for (int j2 = 0; j2 < 8; ++j2) w[j2] = (unsigned)G2(proj, po + C_I + (2 * j2) * NINP) | ((unsigned)G2(proj, po + C_I + (2 * j2 + 1) * NINP) << 16);
#pragma unroll
        for (int j = 0; j < 16; ++j) { const float gl = bf2f(fraw[j]); run += gl; bl[j] = run; kk[j] = 1.0f - __expf(gl); qv[j] = bf2f(qraw[j]); }
        Tsum[I * 128 + k] = run;
        LAS u32x4* dst = (LAS u32x4*)(vT + k * 72 + 16 * I); dst[0] = (u32x4){w[0], w[1], w[2], w[3]}; dst[1] = (u32x4){w[4], w[5], w[6], w[7]};
    }
    LBAR();
    const float T0 = Tsum[k], T1 = Tsum[128 + k], T2 = Tsum[256 + k], T3 = Tsum[384 + k];
    const float start = (I > 0 ? T0 : 0.f) + (I > 1 ? T1 : 0.f) + (I > 2 ? T2 : 0.f), btot = (T0 + T1) + (T2 + T3);
    if (!OUT) {
        unsigned w[8]; const float e0 = btot - start;
#pragma unroll
        for (int j2 = 0; j2 < 8; ++j2) w[j2] = pk2(kk[2 * j2] * __expf(e0 - bl[2 * j2]), kk[2 * j2 + 1] * __expf(e0 - bl[2 * j2 + 1]));
        LAS u32x4* dst = (LAS u32x4*)(KdT + k * 72 + 16 * I); dst[0] = (u32x4){w[0], w[1], w[2], w[3]}; dst[1] = (u32x4){w[4], w[5], w[6], w[7]};
        if (I == 0) ((float*)(p.ws + WS_DEC))[(size_t)uh * 128 + k] = __expf(btot);
        LBAR();
#pragma unroll
        for (int n = 0; n < 8; ++n) {
            const f32x4 acc = mma_lds(KdT + 16 * wave * 72, 72, vT + 16 * n * 72, 72, 64, (f32x4){0.f, 0.f, 0.f, 0.f}, lane);
            *(u32x2*)(STb + (unsigned)(so + (16 * n + r) * 128 + 16 * wave + 4 * q)) = (u32x2){pk2(acc[0], acc[1]), pk2(acc[2], acc[3])};
        }
        LBAR();
        return;
    }
    {
        const float es = __expf(start);
#pragma unroll
        for (int j = 0; j < 16; ++j) { const int t = 16 * I + j; const float e1 = qv[j] * __expf(bl[j]); Qt[t * 136 + k] = (bf16)f2bf(e1); Qb[t * 136 + k] = (bf16)f2bf(e1 * es); }
        float Dacc = 0.f;
#pragma unroll
        for (int I2 = 0; I2 < 4; ++I2) {
            if (I2 >= I) { const int pair = I2 * (I2 + 1) / 2 + I;
#pragma unroll
                for (int j = 0; j < 16; ++j) KT[(pair * 16 + j) * 136 + k] = (bf16)f2bf(kk[j] * __expf(Dacc - bl[j]));
                Dacc += (I2 == 0 ? T0 : I2 == 1 ? T1 : I2 == 2 ? T2 : T3); }
        }
#pragma unroll
        for (int i = 0; i < 4; ++i) { const int e = tid + 512 * i; *(LAS u32x4*)(Sl + (e >> 4) * 136 + 8 * (e & 15)) = Sreg[i]; }
    }
    LBAR();
    {
        const int I2 = wave >> 1;
#pragma unroll
        for (int jj = 0; jj < 2; ++jj) { const int J = 2 * (wave & 1) + jj; f32x4 sc = (f32x4){0.f, 0.f, 0.f, 0.f};
            if (J <= I2) { const int pair = I2 * (I2 + 1) / 2 + J; sc = mma_lds(Qt + 16 * I2 * 136, 136, KT + pair * 16 * 136, 136, 128, sc, lane);
                if (J == I2) {
#pragma unroll
                    for (int j = 0; j < 4; ++j) if (r > 4 * q + j) sc[j] = 0.f; } }
#pragma unroll
            for (int j = 0; j < 4; ++j) P[(16 * I2 + 4 * q + j) * 72 + 16 * J + r] = (bf16)f2bf(sc[j]); }
    }
    LBAR();
    {
        f32x4 o[4]; float ssq[4] = {0.f, 0.f, 0.f, 0.f};
#pragma unroll
        for (int c4 = 0; c4 < 4; ++c4) { const int n = 4 * (wave & 1) + c4;
            f32x4 acc = mma_lds(P + 16 * rt * 72, 72, vT + 16 * n * 72, 72, 64, (f32x4){0.f, 0.f, 0.f, 0.f}, lane);
            acc = mma_lds(Qb + 16 * rt * 136, 136, Sl + 16 * n * 136, 136, 128, acc, lane);
            o[c4] = acc;
#pragma unroll
            for (int j = 0; j < 4; ++j) ssq[j] += acc[j] * acc[j]; }
#pragma unroll
        for (int j = 0; j < 4; ++j) { float s = ssq[j]; s += __shfl_xor(s, 1); s += __shfl_xor(s, 2); s += __shfl_xor(s, 4); s += __shfl_xor(s, 8); if (r == 0) red[(16 * rt + 4 * q + j) * 2 + (wave & 1)] = s; }
        LBAR();
        bf16* mixin = (bf16*)(p.ws + WS_XN);
#pragma unroll
        for (int j = 0; j < 4; ++j) { const int t = 16 * rt + 4 * q + j; const float rs = rsqrtf((red[t * 2] + red[t * 2 + 1]) * (1.0f / 128.0f) + EPS);
#pragma unroll
            for (int c4 = 0; c4 < 4; ++c4) { const int v = 16 * (4 * (wave & 1) + c4) + r;
                mixin[(unsigned)((row0 + t) * 2048 + h * 128 + v)] = (bf16)f2bf(o[c4][j] * rs * p.hgrn_nw[h * 128 + v] * bf2f(greg[j * 4 + c4])); } }
    }
    LBAR();
}

template <bool OUT>
__device__ __forceinline__ void ssd_unit(LAS unsigned char* lds, const Params& p, int u) {
    const int tid = threadIdx.x, lane = tid & 63, wave = __builtin_amdgcn_readfirstlane(tid >> 6), r = lane & 15, q = lane >> 4;
    const int b = u >> 7, c = (u >> 1) & 63, g = u & 1;
    const unsigned row0 = (unsigned)(b * SEQ + c * 128), rowb = row0 * NINP;
    const bool first = (c == 0);
    const bf16* proj = (const bf16*)(p.ws + WS_PROJ); bf16* mixin = (bf16*)(p.ws + WS_XN);
    LAS float* acs = (LAS float*)lds;
    LAS float* dtl = acs + 1024;
    LAS bf16* Cn = (LAS bf16*)(lds + 8192);
    LAS bf16* Bn = Cn + 128 * 136;
    LAS bf16* xT = Bn + 128 * 136;
    LAS bf16* xsN = xT + 64 * 136;
    LAS float* red = (LAS float*)(xsN + 128 * 72);
    LAS bf16* PV = (LAS bf16*)(lds + 114176);
    LAS bf16* hal = PV + 64 * 136;
    const int headw = g * 8 + wave;
    const float d0 = bf2f(G2(proj, rowb + lane * NINP + C_DT + headw)), d1 = bf2f(G2(proj, rowb + (64 + lane) * NINP + C_DT + headw));
    u32x4 braw[OUT ? 8 : 4];
#pragma unroll
    for (int i = 0; i < (OUT ? 8 : 4); ++i) { const int e = tid + 512 * i, which = e >> 11, e2 = e & 2047;
        braw[i] = G16(proj, rowb + (e2 >> 4) * NINP + C_XBC + 1024 + which * 256 + g * 128 + 8 * (e2 & 15)); }
    const int cch = tid & 127, cwhich = (tid >> 7) & 1, cseg = tid >> 8, ccol = 1024 + cwhich * 256 + g * 128 + cch;
    const bool cact = OUT || cwhich == 0;
    float r0 = 0.f, r1 = 0.f, r2 = 0.f;
    if (cact && cseg == 0 && !first) { const unsigned o = rowb + C_XBC + ccol; r0 = bf2f(G2(proj, o - 3 * NINP)); r1 = bf2f(G2(proj, o - 2 * NINP)); r2 = bf2f(G2(proj, o - NINP)); }
    {
        const float A = -expf(p.a_log[headw]);
        float a0 = d0 * A, a1 = d1 * A;
#pragma unroll
        for (int o = 1; o < 64; o <<= 1) { const float t0 = __shfl_up(a0, o), t1 = __shfl_up(a1, o); if (lane >= o) { a0 += t0; a1 += t1; } }
        a1 += __shfl(a0, 63);
        acs[wave * 128 + lane] = a0; acs[wave * 128 + 64 + lane] = a1; dtl[wave * 128 + lane] = d0; dtl[wave * 128 + 64 + lane] = d1;
        if (!OUT && lane == 63) ((float*)(p.ws + WS_DEC_S))[(b * 16 + headw) * 64 + c] = __expf(a1);
#pragma unroll
        for (int i = 0; i < (OUT ? 8 : 4); ++i) { const int e = tid + 512 * i, which = e >> 11, e2 = e & 2047;
            *(LAS u32x4*)((which ? Cn : Bn) + (e2 >> 4) * 136 + 8 * (e2 & 15)) = braw[i]; }
    }
    LBAR();
    LAS bf16* csrc = cwhich ? Cn : Bn;
    if (cact && cseg == 1) { r0 = bf2f(csrc[61 * 136 + cch]); r1 = bf2f(csrc[62 * 136 + cch]); r2 = bf2f(csrc[63 * 136 + cch]); }
    LBAR();
    if (cact) {
        const float w0 = p.conv_w[ccol], w1 = p.conv_w[XBC_W + ccol], w2 = p.conv_w[2 * XBC_W + ccol], w3 = p.conv_w[3 * XBC_W + ccol], bias = p.conv_b[ccol];
        const int tb = 64 * cseg;
#pragma unroll 8
        for (int i = 0; i < 64; ++i) { const float r3 = bf2f(csrc[(tb + i) * 136 + cch]); const float val = silu(bias + w0 * r0 + w1 * r1 + w2 * r2 + w3 * r3); r0 = r1; r1 = r2; r2 = r3;
            if (OUT) csrc[(tb + i) * 136 + cch] = (bf16)f2bf(val); else Cn[cch * 136 + tb + i] = (bf16)f2bf(val); }
    }
    LBAR();
    f32x4 cb[8];
    if (OUT) {
#pragma unroll
        for (int n8 = 0; n8 < 8; ++n8) cb[n8] = mma_lds(Cn + 16 * wave * 136, 136, Bn + 16 * n8 * 136, 136, 128, (f32x4){0.f, 0.f, 0.f, 0.f}, lane);
        LBAR();
    }
    float ssq[4] = {0.f, 0.f, 0.f, 0.f};
    float dmask[4];
#pragma unroll
    for (int j = 0; j < 4; ++j) dmask[j] = (r <= 4 * q + j) ? 1.0f : 0.0f;
    const int pp = tid & 63, xseg = tid >> 6, xtb = 16 * xseg;
    for (int hh = 0; hh < 8; ++hh) {
        const int head = g * 8 + hh, xcol = g * 512 + hh * 64;
        const bf16* stS = (const bf16*)(p.ws + WS_ST_S); const unsigned so = (unsigned)((b * 16 + head) * 64 + c) * 8192u;
        u32x4 xraw[2], pvr[2]; unsigned short zreg[16]; unsigned short hraw = 0;
#pragma unroll
        for (int i = 0; i < 2; ++i) { const int e = tid + 512 * i; xraw[i] = G16(proj, rowb + (e >> 3) * NINP + C_XBC + xcol + 8 * (e & 7)); }
        if (tid < 192 && !first) hraw = G2(proj, rowb - (3 - (tid >> 6)) * NINP + C_XBC + xcol + pp);
        if (OUT) {
#pragma unroll
            for (int i = 0; i < 2; ++i) { const int e = tid + 512 * i; pvr[i] = G16(stS, so + (e >> 4) * 128 + 8 * (e & 15)); }
        }
#pragma unroll
        for (int i = 0; i < 2; ++i) { const int e = tid + 512 * i; *(LAS u32x4*)(xsN + (e >> 3) * 72 + 8 * (e & 7)) = xraw[i]; }
        if (tid < 192) hal[tid] = hraw;
        if (OUT) {
#pragma unroll
            for (int i = 0; i < 2; ++i) { const int e = tid + 512 * i; *(LAS u32x4*)(PV + (e >> 4) * 136 + 8 * (e & 15)) = pvr[i]; }
        }
        LBAR();
        float x0, x1, x2;
        if (xseg == 0) { x0 = bf2f(hal[pp]); x1 = bf2f(hal[64 + pp]); x2 = bf2f(hal[128 + pp]); }
        else { x0 = bf2f(xsN[(xtb - 3) * 72 + pp]); x1 = bf2f(xsN[(xtb - 2) * 72 + pp]); x2 = bf2f(xsN[(xtb - 1) * 72 + pp]); }
        LBAR();
        {
            const int col = xcol + pp;
            const float w0 = p.conv_w[col], w1 = p.conv_w[XBC_W + col], w2 = p.conv_w[2 * XBC_W + col], w3 = p.conv_w[3 * XBC_W + col], bias = p.conv_b[col];
            const float alast = acs[hh * 128 + 127];
            unsigned w[8]; float prev = 0.f;
#pragma unroll
            for (int i = 0; i < 16; ++i) { const int s = xtb + i; const float x3 = bf2f(xsN[s * 72 + pp]); const float val = silu(bias + w0 * x0 + w1 * x1 + w2 * x2 + w3 * x3); x0 = x1; x1 = x2; x2 = x3;
                float xv = val * dtl[hh * 128 + s];
                if (OUT) xsN[s * 72 + pp] = (bf16)f2bf(val); else xv *= __expf(alast - acs[hh * 128 + s]);
                if (i & 1) w[i >> 1] = pk2(prev, xv); else prev = xv;
                if ((i & 3) == 3) __builtin_amdgcn_sched_barrier(0); }
            LAS u32x4* dst = (LAS u32x4*)(xT + pp * 136 + xtb); dst[0] = (u32x4){w[0], w[1], w[2], w[3]}; dst[1] = (u32x4){w[4], w[5], w[6], w[7]};
        }
        __builtin_amdgcn_sched_barrier(0);
        if (OUT) {
            LAS bf16* W = Bn;
#pragma unroll
            for (int n8 = 0; n8 < 8; ++n8)
#pragma unroll
                for (int j = 0; j < 4; ++j) { const int t = 16 * wave + 4 * q + j, s = 16 * n8 + r;
                    const float mk = (n8 < wave) ? 1.0f : ((n8 == wave) ? dmask[j] : 0.0f);
                    const float val = cb[n8][j] * __expf(fminf(acs[hh * 128 + t] - acs[hh * 128 + s], 0.f)) * mk; W[t * 136 + s] = (bf16)f2bf(val);
                    if (j == 3 && (n8 & 1)) __builtin_amdgcn_sched_barrier(0); }
        }
        LBAR();
        if (OUT) {
            const float Dk = p.d_skip[head];
#pragma unroll
            for (int c4 = 0; c4 < 4; ++c4) {
#pragma unroll
                for (int j = 0; j < 4; ++j) zreg[c4 * 4 + j] = G2(proj, rowb + (16 * wave + 4 * q + j) * NINP + C_Z + head * 64 + 16 * c4 + r);
                const f32x4 accd = mma_lds(Bn + 16 * wave * 136, 136, xT + 16 * c4 * 136, 136, 128, (f32x4){0.f, 0.f, 0.f, 0.f}, lane);
                __builtin_amdgcn_sched_barrier(0);
                const f32x4 acco = mma_lds(Cn + 16 * wave * 136, 136, PV + 16 * c4 * 136, 136, 128, (f32x4){0.f, 0.f, 0.f, 0.f}, lane);
#pragma unroll
                for (int j = 0; j < 4; ++j) { const int t = 16 * wave + 4 * q + j, pcol = 16 * c4 + r;
                    float y = accd[j] + __expf(acs[hh * 128 + t]) * acco[j] + Dk * bf2f(xsN[t * 72 + pcol]);
                    y *= bf2f(zreg[c4 * 4 + j]); ssq[j] += y * y;
                    mixin[(unsigned)((row0 + t) * 2048 + 1024 + xcol + pcol)] = (bf16)f2bf(y * p.ssd_nw[xcol + pcol]); }
                __builtin_amdgcn_sched_barrier(0);
            }
        } else {
            bf16* Lst = (bf16*)(p.ws + WS_ST_S);
#pragma unroll
            for (int c4 = 0; c4 < 4; ++c4) {
                const f32x4 acc = mma_lds(Cn + 16 * wave * 136, 136, xT + 16 * c4 * 136, 136, 128, (f32x4){0.f, 0.f, 0.f, 0.f}, lane);
                *(u32x2*)(Lst + (unsigned)(so + (16 * c4 + r) * 128 + 16 * wave + 4 * q)) = (u32x2){pk2(acc[0], acc[1]), pk2(acc[2], acc[3])};
            }
        }
        LBAR();
    }
    if (OUT) {
#pragma unroll
        for (int j = 0; j < 4; ++j) { float s = ssq[j]; s += __shfl_xor(s, 1); s += __shfl_xor(s, 2); s += __shfl_xor(s, 4); s += __shfl_xor(s, 8); if (r == 0) red[16 * wave + 4 * q + j] = rsqrtf(s * (1.0f / 512.0f) + EPS); }
        __syncthreads();
        for (int e = tid; e < 128 * 64; e += 512) { const int t = e >> 6, c8 = e & 63; const float rs = red[t];
            u32x4* ptr = (u32x4*)(mixin + (unsigned)((row0 + t) * 2048 + 1024 + g * 512 + 8 * c8)); u32x4 w = *ptr;
            w.x = pk2(bflo(w.x) * rs, bfhi(w.x) * rs); w.y = pk2(bflo(w.y) * rs, bfhi(w.y) * rs); w.z = pk2(bflo(w.z) * rs, bfhi(w.z) * rs); w.w = pk2(bflo(w.w) * rs, bfhi(w.w) * rs); *ptr = w; }
        LBAR();
    }
}

__device__ __forceinline__ void state_scan(const Params& p, int gt, int GT) {
    for (int e = gt; e < 131072; e += GT) {
        if (e < 65536) {
            const int bh = e >> 12, off4 = e & 4095;
            bf16* st = (bf16*)(p.ws + WS_ST) + (size_t)bh * 128 * 16384 + off4 * 4; const float* dec = (const float*)(p.ws + WS_DEC) + (size_t)bh * 128 * 128 + (off4 & 31) * 4;
            f32x4 S = (f32x4){0.f, 0.f, 0.f, 0.f};
            for (int c0 = 0; c0 < 128; c0 += 8) {
                u32x2 L[8]; f32x4 d[8];
#pragma unroll
                for (int i = 0; i < 8; ++i) { L[i] = *(const u32x2*)(st + (size_t)(c0 + i) * 16384); d[i] = *(const f32x4*)(dec + (c0 + i) * 128); }
#pragma unroll
                for (int i = 0; i < 8; ++i) { *(u32x2*)(st + (size_t)(c0 + i) * 16384) = (u32x2){pk2(S.x, S.y), pk2(S.z, S.w)};
                    S.x = d[i].x * S.x + bflo(L[i].x); S.y = d[i].y * S.y + bfhi(L[i].x); S.z = d[i].z * S.z + bflo(L[i].y); S.w = d[i].w * S.w + bfhi(L[i].y); }
            }
        } else {
            const int e2 = e - 65536, bhd = e2 >> 11, off4 = e2 & 2047;
            bf16* st = (bf16*)(p.ws + WS_ST_S) + (size_t)bhd * 64 * 8192 + off4 * 4; const float* dec = (const float*)(p.ws + WS_DEC_S) + bhd * 64;
            f32x4 S = (f32x4){0.f, 0.f, 0.f, 0.f};
            for (int c0 = 0; c0 < 64; c0 += 8) {
                u32x2 L[8]; float d[8];
#pragma unroll
                for (int i = 0; i < 8; ++i) { L[i] = *(const u32x2*)(st + (size_t)(c0 + i) * 8192); d[i] = dec[c0 + i]; }
#pragma unroll
                for (int i = 0; i < 8; ++i) { *(u32x2*)(st + (size_t)(c0 + i) * 8192) = (u32x2){pk2(S.x, S.y), pk2(S.z, S.w)};
                    S.x = d[i] * S.x + bflo(L[i].x); S.y = d[i] * S.y + bfhi(L[i].x); S.z = d[i] * S.z + bflo(L[i].y); S.w = d[i] * S.w + bfhi(L[i].y); }
            }
        }
    }
}

#ifndef R_GEMM
#define R_GEMM 1
#endif
#ifndef R_P0
#define R_P0 1
#endif
#ifndef R_MIXA
#define R_MIXA 1
#endif
#ifndef R_MIXCS
#define R_MIXCS 1
#endif
#ifndef R_MIXC
#define R_MIXC 1
#endif
#ifndef MIX_MODE
#define MIX_MODE 1
#endif
__global__ void __launch_bounds__(512) fwd_kernel(Params p) {
    extern __shared__ __attribute__((aligned(16))) unsigned char lds_raw[];
    LAS unsigned char* lds = (LAS unsigned char*)lds_raw;
    cg::grid_group grid = cg::this_grid();
    volatile LAS unsigned* bst = (volatile LAS unsigned*)(lds + LDS_BYTES - 64);
    if (threadIdx.x < 2) bst[threadIdx.x] = 0u;
    __syncthreads();
    const XcdBarrier xbar = xcd_barrier_post((unsigned*)(p.ws + WS_CTL), bst);
#define GSYNC() xcd_barrier(xbar)
    const int tid = threadIdx.x, lane = tid & 63, wave = __builtin_amdgcn_readfirstlane(tid >> 6);
    const int G = gridDim.x, gw = blockIdx.x * 8 + wave, NGW = G * 8;
    bf16* WIN = (bf16*)(p.ws + WS_WIN); bf16* WOUT = (bf16*)(p.ws + WS_WOUT); bf16* WGU = (bf16*)(p.ws + WS_WGU); bf16* WDN = (bf16*)(p.ws + WS_WDN);
    bf16* XN = (bf16*)(p.ws + WS_XN); bf16* PROJ = (bf16*)(p.ws + WS_PROJ); bf16* HID = (bf16*)(p.ws + WS_PROJ); bf16* MIXO = (bf16*)(p.ws + WS_ST); bf16* FF = (bf16*)(p.ws + WS_ST);

    for (int rep = 0; rep < R_P0; ++rep) {
        LAS float* scr = (LAS float*)(lds + wave * 16384);
        constexpr int I_IN = 32 * (NINP / 32), I_OUT = 32 * (D / 32), I_G = 32 * (DFF / 32), I_DN = (DFF / 64) * (D / 32);
        constexpr int NITEMS = I_IN + I_OUT + 2 * I_G + I_DN;
        for (int it = gw; it < NITEMS; it += NGW) {
            int r = it;
            if (r < I_IN) { const int nb = NINP / 32, kb = r / nb, n0 = 32 * (r % nb); transpose_item(p.w_in, D, NIN, WIN, 64 * kb, n0, n0, scr, lane); continue; } r -= I_IN;
            if (r < I_OUT) { const int nb = D / 32, kb = r / nb, n0 = 32 * (r % nb); transpose_item(p.w_out, D, D, WOUT, 64 * kb, n0, n0, scr, lane); continue; } r -= I_OUT;
            if (r < I_G) { const int nb = DFF / 32, kb = r / nb, n0 = 32 * (r % nb); transpose_item(p.w_gate, D, DFF, WGU, 64 * kb, n0, 256 * (n0 >> 7) + (n0 & 127), scr, lane); continue; } r -= I_G;
            if (r < I_G) { const int nb = DFF / 32, kb = r / nb, n0 = 32 * (r % nb); transpose_item(p.w_up, D, DFF, WGU, 64 * kb, n0, 256 * (n0 >> 7) + 128 + (n0 & 127), scr, lane); continue; } r -= I_G;
            { const int nb = D / 32, kb = r / nb, n0 = 32 * (r % nb); transpose_item(p.w_down, DFF, D, WDN, 64 * kb, n0, n0, scr, lane); }
        }
        if (blockIdx.x == 0) for (int i = tid; i < 1024; i += 512) ((float*)(p.ws + WS_LB))[i] = 1.0f / (1.0f + expf(p.lb_logits[1024 + i] - p.lb_logits[i]));
        for (int m = gw; m < M; m += NGW) rms_row_to_bf16(p.x + (size_t)m * D, p.pre_mix_w, XN + (size_t)m * D, lane);
    }
    grid.sync();
    {
        pg8::Gemm g{XN, WIN, M, NINP, D}; pg8::StaticOrder S; S.init(M, NINP, G, (int)blockIdx.x, R_GEMM); pg8::EpiProj E{PROJ, NINP, (const float*)(p.ws + WS_LB), p.dt_bias};
        pg8::gemm_phase<pg8::EpiProj, pg8::StaticOrder, true, true>(lds, g, S, E);
    }
    GSYNC();
    if (MIX_MODE != 0) {
        for (int rep = 0; rep < R_MIXA; ++rep) {
            if (rep) GSYNC();
            if (MIX_MODE != 3) for (int u = blockIdx.x; u < 256; u += G) ssd_unit<false>(lds, p, u);
            if (MIX_MODE != 2) for (int u = blockIdx.x; u < 2048; u += G) hgrn_unit<false>(lds, p, u);
        }
        GSYNC();
        state_scan(p, (int)blockIdx.x * 512 + tid, G * 512);
        GSYNC();
        for (int rep = 0; rep < R_MIXC; ++rep) {
            if (MIX_MODE != 3) for (int u = blockIdx.x; u < 256 * R_MIXCS; u += G) ssd_unit<true>(lds, p, u & 255);
            if (MIX_MODE != 2) for (int u = blockIdx.x; u < 2048; u += G) hgrn_unit<true>(lds, p, u);
        }
    }
    GSYNC();
    {
        pg8::Gemm g{XN, WOUT, M, D, D}; pg8::StaticOrder S; S.init(M, D, G, (int)blockIdx.x, R_GEMM); pg8::EpiBf16 E{MIXO, D};
        pg8::gemm_phase<pg8::EpiBf16, pg8::StaticOrder, true, true>(lds, g, S, E);
    }
    GSYNC();
    for (int rep = 0; rep < R_P0; ++rep)
    for (int m = gw; m < M; m += NGW) {
        const float* xr = p.x + (size_t)m * D; const bf16* mr = MIXO + (size_t)m * D; float* orow = p.out + (size_t)m * D; bf16* xn = XN + (size_t)m * D;
        u32x4 mw[4]; float ss = 0.f;
#pragma unroll
        for (int j = 0; j < 4; ++j) { mw[j] = *(const u32x4*)(mr + 8 * (lane + 64 * j));
            const float a0 = bflo(mw[j].x), a1 = bfhi(mw[j].x), a2 = bflo(mw[j].y), a3 = bfhi(mw[j].y), a4 = bflo(mw[j].z), a5 = bfhi(mw[j].z), a6 = bflo(mw[j].w), a7 = bfhi(mw[j].w);
            ss += (a0 * a0 + a1 * a1) + (a2 * a2 + a3 * a3) + (a4 * a4 + a5 * a5) + (a6 * a6 + a7 * a7); }
        const float r1 = rsqrtf(wave_sum(ss) * (1.0f / D) + EPS);
        f32x4 x1[8]; float ss1 = 0.f;
#pragma unroll
        for (int j = 0; j < 4; ++j) { const int base = 8 * (lane + 64 * j);
            const f32x4 xa = *(const f32x4*)(xr + base), xb = *(const f32x4*)(xr + base + 4), wa = *(const f32x4*)(p.post_mix_w + base), wb = *(const f32x4*)(p.post_mix_w + base + 4);
            f32x4 a, b2;
            a.x = xa.x + bflo(mw[j].x) * r1 * wa.x; a.y = xa.y + bfhi(mw[j].x) * r1 * wa.y; a.z = xa.z + bflo(mw[j].y) * r1 * wa.z; a.w = xa.w + bfhi(mw[j].y) * r1 * wa.w;
            b2.x = xb.x + bflo(mw[j].z) * r1 * wb.x; b2.y = xb.y + bfhi(mw[j].z) * r1 * wb.y; b2.z = xb.z + bflo(mw[j].w) * r1 * wb.z; b2.w = xb.w + bfhi(mw[j].w) * r1 * wb.w;
            x1[2 * j] = a; x1[2 * j + 1] = b2; *(f32x4*)(orow + base) = a; *(f32x4*)(orow + base + 4) = b2;
            ss1 += (a.x * a.x + a.y * a.y) + (a.z * a.z + a.w * a.w) + (b2.x * b2.x + b2.y * b2.y) + (b2.z * b2.z + b2.w * b2.w); }
        const float r2 = rsqrtf(wave_sum(ss1) * (1.0f / D) + EPS);
#pragma unroll
        for (int j = 0; j < 4; ++j) { const int base = 8 * (lane + 64 * j); const f32x4 w0 = *(const f32x4*)(p.pre_ffn_w + base), w1 = *(const f32x4*)(p.pre_ffn_w + base + 4); const f32x4 a = x1[2 * j], b2 = x1[2 * j + 1];
            u32x4 o; o.x = pk2(a.x * r2 * w0.x, a.y * r2 * w0.y); o.y = pk2(a.z * r2 * w0.z, a.w * r2 * w0.w); o.z = pk2(b2.x * r2 * w1.x, b2.y * r2 * w1.y); o.w = pk2(b2.z * r2 * w1.z, b2.w * r2 * w1.w);
            *(u32x4*)(xn + base) = o; }
    }
    GSYNC();
    {
        pg8::Gemm g{XN, WGU, M, NGU, D}; pg8::StaticOrder S; S.init(M, NGU, G, (int)blockIdx.x, R_GEMM); pg8::EpiSwiglu E{HID, DFF};
        pg8::gemm_phase<pg8::EpiSwiglu, pg8::StaticOrder, true, true>(lds, g, S, E);
    }
    GSYNC();
    {
        pg8::Gemm g{HID, WDN, M, D, DFF}; pg8::StaticOrder S; S.init(M, D, G, (int)blockIdx.x, R_GEMM); pg8::EpiBf16 E{FF, D};
        pg8::gemm_phase<pg8::EpiBf16, pg8::StaticOrder, true, true>(lds, g, S, E);
    }
    GSYNC();
    for (int m = gw; m < M; m += NGW) {
        const bf16* fr = FF + (size_t)m * D; float* orow = p.out + (size_t)m * D;
        u32x4 mw[4]; float ss = 0.f;
#pragma unroll
        for (int j = 0; j < 4; ++j) { mw[j] = *(const u32x4*)(fr + 8 * (lane + 64 * j));
            const float a0 = bflo(mw[j].x), a1 = bfhi(mw[j].x), a2 = bflo(mw[j].y), a3 = bfhi(mw[j].y), a4 = bflo(mw[j].z), a5 = bfhi(mw[j].z), a6 = bflo(mw[j].w), a7 = bfhi(mw[j].w);
            ss += (a0 * a0 + a1 * a1) + (a2 * a2 + a3 * a3) + (a4 * a4 + a5 * a5) + (a6 * a6 + a7 * a7); }
        const float r1 = rsqrtf(wave_sum(ss) * (1.0f / D) + EPS);
#pragma unroll
        for (int j = 0; j < 4; ++j) { const int base = 8 * (lane + 64 * j);
            const f32x4 xa = *(const f32x4*)(orow + base), xb = *(const f32x4*)(orow + base + 4), wa = *(const f32x4*)(p.post_ffn_w + base), wb = *(const f32x4*)(p.post_ffn_w + base + 4);
            f32x4 a, b2;
            a.x = xa.x + bflo(mw[j].x) * r1 * wa.x; a.y = xa.y + bfhi(mw[j].x) * r1 * wa.y; a.z = xa.z + bflo(mw[j].y) * r1 * wa.z; a.w = xa.w + bfhi(mw[j].y) * r1 * wa.w;
            b2.x = xb.x + bflo(mw[j].z) * r1 * wb.x; b2.y = xb.y + bfhi(mw[j].z) * r1 * wb.y; b2.z = xb.z + bflo(mw[j].w) * r1 * wb.z; b2.w = xb.w + bfhi(mw[j].w) * r1 * wb.w;
            *(f32x4*)(orow + base) = a; *(f32x4*)(orow + base + 4) = b2; }
    }
}

extern "C" void kernel_launch(void* const* d_in, const int* in_sizes, int n_in, void* d_out, int out_size, void* d_ws, size_t ws_size, hipStream_t stream) {
    static int grid = 0;
    if (grid == 0) {
        if (n_in != 18 || in_sizes[0] != M * D || out_size != M * D || ws_size < WS_END) { fprintf(stderr, "kernel_launch: unexpected shapes (n_in %d, in0 %d, out %d, ws %zu)\n", n_in, n_in > 0 ? in_sizes[0] : -1, out_size, ws_size); grid = -1; return; }
        int dev = 0, cus = 0, per_cu = 0;
        if (hipGetDevice(&dev) != hipSuccess || hipDeviceGetAttribute(&cus, hipDeviceAttributeMultiprocessorCount, dev) != hipSuccess) { grid = -1; return; }
        if (hipFuncSetAttribute((const void*)fwd_kernel, hipFuncAttributeMaxDynamicSharedMemorySize, LDS_BYTES) != hipSuccess) { fprintf(stderr, "kernel_launch: hipFuncSetAttribute failed\n"); grid = -1; return; }
        if (hipOccupancyMaxActiveBlocksPerMultiprocessor(&per_cu, (const void*)fwd_kernel, 512, LDS_BYTES) != hipSuccess || per_cu < 1) { fprintf(stderr, "kernel_launch: occupancy query says %d\n", per_cu); per_cu = 1; }
        (void)hipGetLastError();
        grid = cus;
    }
    if (grid < 0) return;
    Params p{};
    p.x = (const float*)d_in[0]; p.pre_mix_w = (const float*)d_in[1]; p.w_in = (const float*)d_in[2]; p.lb_logits = (const float*)d_in[3]; p.conv_w = (const float*)d_in[4]; p.conv_b = (const float*)d_in[5];
    p.dt_bias = (const float*)d_in[6]; p.a_log = (const float*)d_in[7]; p.d_skip = (const float*)d_in[8]; p.hgrn_nw = (const float*)d_in[9]; p.ssd_nw = (const float*)d_in[10]; p.w_out = (const float*)d_in[11];
    p.post_mix_w = (const float*)d_in[12]; p.pre_ffn_w = (const float*)d_in[13]; p.w_gate = (const float*)d_in[14]; p.w_up = (const float*)d_in[15]; p.w_down = (const float*)d_in[16]; p.post_ffn_w = (const float*)d_in[17];
    p.out = (float*)d_out; p.ws = (unsigned char*)d_ws;
    if (hipMemsetAsync(d_ws, 0, CTL_ZERO_BYTES, stream) != hipSuccess) { fprintf(stderr, "kernel_launch: memset failed\n"); return; }
    void* args[] = {&p};
    hipError_t e = hipLaunchCooperativeKernel((const void*)fwd_kernel, dim3(grid), dim3(512), args, LDS_BYTES, stream);
    if (e != hipSuccess) fprintf(stderr, "kernel_launch: cooperative launch failed: %s (grid %d)\n", hipGetErrorString(e), grid);
}
```

```cpp
#include <hip/hip_runtime.h>
#include <hip/hip_cooperative_groups.h>
#include <cstdio>
#include <cstdint>
namespace cg = cooperative_groups;
namespace pg8 {
#define PG8_LAS __attribute__((address_space(3)))
typedef unsigned short bf16_t;
typedef short bf16x8 __attribute__((ext_vector_type(8)));
typedef float f32x4 __attribute__((ext_vector_type(4)));
typedef unsigned u32x4 __attribute__((ext_vector_type(4)));
constexpr int BM = 256, BK = 64, HALF = 128, HTB = HALF * BK * 2  , STAGE_BYTES = 8 * HTB, NXCD = 8, WGM = 8;

__host__ __device__ __forceinline__ int lds_byte(int r, int c) { const int st = (r >> 4) * 2 + (c >> 5), rr = r & 15, cc = c & 31, ob = rr * 64 + cc * 2; return st * 1024 + (ob ^ (((ob >> 9) & 1) << 5)); }
__host__ __device__ __forceinline__ void stage_rc(int b, int& R, int& C) { const int st = b / 1024, sb = b % 1024, swz = sb ^ (((sb >> 9) & 1) << 5); R = (st >> 1) * 16 + swz / 64; C = (st & 1) * 32 + (swz % 64) / 2; }
__host__ __device__ __forceinline__ int perm32(int rho) { const int n = rho >> 4, i = rho & 15; return 8 * (i >> 2) + 4 * n + (i & 3); }

struct Unit { int pm, pn; };
struct Gemm { const bf16_t* A; const bf16_t* Bt; int M, N, K; };

struct StaticOrder {
    int nM, nN, nwg, G, c, reps;
    __host__ __device__ void init(int M, int N, int G_, int c_, int reps_ = 1) { nM = M / BM; nN = N / BM; nwg = nM * nN; G = G_; c = c_; reps = reps_; }
    __host__ __device__ bool next(int i, Unit& u) const {
        const long L = (long)i * G + c; if (L >= (long)nwg * reps) return false;
        int wgid = (int)(L % nwg); { const int q = nwg / NXCD, r = nwg % NXCD, xcd = wgid % NXCD, off = wgid / NXCD; wgid = (xcd < r ? xcd * (q + 1) : r * (q + 1) + (xcd - r) * q) + off; }
        const int nig = WGM * nN, gid = wgid / nig, fm = gid * WGM, gsz = (nM - fm) < WGM ? (nM - fm) : WGM;
        u.pm = fm + ((wgid % nig) % gsz); u.pn = (wgid % nig) / gsz; return true;
    }
    __device__ __forceinline__ void a_ready(const Unit&) const {}
    __device__ __forceinline__ void done(const Unit&) const {}
};

__device__ __forceinline__ unsigned cvt_pk_bf16(float lo, float hi) { unsigned r; asm volatile("v_cvt_pk_bf16_f32 %0, %1, %2" : "=v"(r) : "v"(lo), "v"(hi)); return r; }
struct EpiBf16 {
    static constexpr bool PERM = true, AFTER_DRAIN = false;
    bf16_t* O; int ldc;
    __device__ __forceinline__ void operator()(const f32x4 (&acc)[2][2][4][2], const Unit& u, int wr, int wc, int fr, int fq) const {
        const int row0 = u.pm * BM + wr * 64 + fr; const int col0 = u.pn * BM + wc * 32 + 8 * fq;
#pragma unroll
        for (int ai = 0; ai < 2; ++ai)
#pragma unroll
            for (int m = 0; m < 4; ++m) { bf16_t* rowp = O + (size_t)(row0 + ai * HALF + m * 16) * ldc + col0;
#pragma unroll
                for (int bj = 0; bj < 2; ++bj) { const f32x4 v0 = acc[ai][bj][m][0], v1 = acc[ai][bj][m][1];
                    u32x4 w; w.x = cvt_pk_bf16(v0[0], v0[1]); w.y = cvt_pk_bf16(v0[2], v0[3]); w.z = cvt_pk_bf16(v1[0], v1[1]); w.w = cvt_pk_bf16(v1[2], v1[3]);
                    *(u32x4*)(rowp + bj * HALF) = w; } }
    }
};
__device__ __forceinline__ float silu_f(float v) { return v / (1.0f + __expf(-v)); }
struct EpiSwiglu {
    static constexpr bool PERM = true, AFTER_DRAIN = false;
    bf16_t* O; int ldc;
    __device__ __forceinline__ void operator()(const f32x4 (&acc)[2][2][4][2], const Unit& u, int wr, int wc, int fr, int fq) const {
        const int row0 = u.pm * BM + wr * 64 + fr; const int col0 = u.pn * HALF + wc * 32 + 8 * fq;
#pragma unroll
        for (int ai = 0; ai < 2; ++ai)
#pragma unroll
            for (int m = 0; m < 4; ++m) { bf16_t* rowp = O + (size_t)(row0 + ai * HALF + m * 16) * ldc + col0;
                const f32x4 g0 = acc[ai][0][m][0], g1 = acc[ai][0][m][1], u0 = acc[ai][1][m][0], u1 = acc[ai][1][m][1];
                u32x4 w; w.x = cvt_pk_bf16(silu_f(g0[0]) * u0[0], silu_f(g0[1]) * u0[1]); w.y = cvt_pk_bf16(silu_f(g0[2]) * u0[2], silu_f(g0[3]) * u0[3]);
                w.z = cvt_pk_bf16(silu_f(g1[0]) * u1[0], silu_f(g1[1]) * u1[1]); w.w = cvt_pk_bf16(silu_f(g1[2]) * u1[2], silu_f(g1[3]) * u1[3]);
                *(u32x4*)rowp = w; }
    }
};

struct EpiProj {
    static constexpr bool PERM = true, AFTER_DRAIN = false;
    bf16_t* O; int ldc; const float* lbv; const float* dtb;
    template <int MODE> __device__ __forceinline__ static float tf(float v, float a) {
        if (MODE == 1) return silu_f(v) * 0.08838834764831845f;
        if (MODE == 2) return __logf(a + (1.0f - a) * __builtin_amdgcn_rcpf(1.0f + __expf(-v)));
        if (MODE == 3) return silu_f(v);
        if (MODE == 4) { const float x = v + a; return x > 20.f ? x : __logf(1.0f + __expf(x)); }
        return v;
    }
    template <int MODE> __device__ __forceinline__ void run(const f32x4 (&acc)[2][2][4][2], const Unit& u, int wr, int wc, int fr, int fq) const {
        const int row0 = u.pm * BM + wr * 64 + fr; const int col0 = u.pn * BM + wc * 32 + 8 * fq;
#pragma unroll
        for (int bj = 0; bj < 2; ++bj) {
            f32x4 a0 = (f32x4){0.f, 0.f, 0.f, 0.f}, a1 = (f32x4){0.f, 0.f, 0.f, 0.f};
            if (MODE == 2) { a0 = *(const f32x4*)(lbv + col0 + bj * HALF - 1024); a1 = *(const f32x4*)(lbv + col0 + bj * HALF - 1024 + 4); }
            if (MODE == 4) { if (col0 + bj * HALF < 6672) { a0 = *(const f32x4*)(dtb + col0 + bj * HALF - 6656); a1 = *(const f32x4*)(dtb + col0 + bj * HALF - 6656 + 4); } }
#pragma unroll
            for (int ai = 0; ai < 2; ++ai)
#pragma unroll
                for (int m = 0; m < 4; ++m) { bf16_t* rowp = O + (size_t)(row0 + ai * HALF + m * 16) * ldc + col0 + bj * HALF;
                    const f32x4 v0 = acc[ai][bj][m][0], v1 = acc[ai][bj][m][1];
                    u32x4 w; w.x = cvt_pk_bf16(tf<MODE>(v0[0], a0[0]), tf<MODE>(v0[1], a0[1])); w.y = cvt_pk_bf16(tf<MODE>(v0[2], a0[2]), tf<MODE>(v0[3], a0[3]));
                    w.z = cvt_pk_bf16(tf<MODE>(v1[0], a1[0]), tf<MODE>(v1[1], a1[1])); w.w = cvt_pk_bf16(tf<MODE>(v1[2], a1[2]), tf<MODE>(v1[3], a1[3]));
                    *(u32x4*)rowp = w; }
        }
    }
    __device__ __forceinline__ void operator()(const f32x4 (&acc)[2][2][4][2], const Unit& u, int wr, int wc, int fr, int fq) const {
        const int pn = u.pn;
        if (pn < 4) run<1>(acc, u, wr, wc, fr, fq);
        else if (pn < 8) run<2>(acc, u, wr, wc, fr, fq);
        else if (pn >= 12 && pn < 20) run<3>(acc, u, wr, wc, fr, fq);
        else if (pn == 26) run<4>(acc, u, wr, wc, fr, fq);
        else run<0>(acc, u, wr, wc, fr, fq);
    }
};

template <class Epi, class Sched, bool ALIGN_EPI = false, bool SP2 = false>
__device__ __forceinline__ void gemm_phase(PG8_LAS unsigned char* lds, const Gemm g, const Sched& S, const Epi& E) {
    int tid_ = threadIdx.x; asm volatile("" : "+v"(tid_));
    const int tid = tid_, wid = __builtin_amdgcn_readfirstlane(tid >> 6), lane = tid & 63, wr = wid >> 2, wc = wid & 3, fr = lane & 15, fq = lane >> 4;
    const int K = g.K, nt = K / BK;
    unsigned voffA[2], voffB[2];
#pragma unroll
    for (int i = 0; i < 2; ++i) { int R, C; stage_rc(tid * 16 + i * 8192, R, C); const int Rb = Epi::PERM ? ((R & ~31) + perm32(R & 31)) : R;
        voffA[i] = (unsigned)(R * K + C) * 2u; voffB[i] = (unsigned)(Rb * K + C) * 2u; }
    const size_t kstep = (size_t)(BK * 2);
    const size_t hstep = (size_t)HALF * K * 2;
    const size_t tstep = 2 * hstep;
    const unsigned ldsw = (unsigned)wid * 1024u;
    const int aoff = lds_byte(wr * 64 + fr, fq * 8), boff = lds_byte(wc * 32 + fr, fq * 8);
#define PG8_SA(b, h) (((b) * 2 + (h)) * HTB)
#define PG8_SB(b, h) ((4 + (b) * 2 + (h)) * HTB)
#define PG8_STAGE(bufoff, gbase, voff) do { _Pragma("unroll") for (int _i = 0; _i < 2; ++_i) \
        __builtin_amdgcn_global_load_lds((const unsigned*)((const char*)(gbase) + (voff)[_i]), (PG8_LAS unsigned*)(lds + (bufoff) + ldsw + _i * 8192), 16, 0, 0); } while (0)
#define PG8_LDA(dst, b, h) do { _Pragma("unroll") for (int m = 0; m < 4; ++m) _Pragma("unroll") for (int k = 0; k < 2; ++k) dst[m][k] = *(const PG8_LAS bf16x8*)(lds + PG8_SA(b, h) + aoff + m * 2048 + k * 1024); } while (0)
#define PG8_LDB(dst, b, h) do { _Pragma("unroll") for (int n = 0; n < 2; ++n) _Pragma("unroll") for (int k = 0; k < 2; ++k) dst[n][k] = *(const PG8_LAS bf16x8*)(lds + PG8_SB(b, h) + boff + n * 2048 + k * 1024); } while (0)
#define PG8_MMA(ai, bj, At, Bt) do { __builtin_amdgcn_s_setprio(1); _Pragma("unroll") for (int m = 0; m < 4; ++m) _Pragma("unroll") for (int n = 0; n < 2; ++n) _Pragma("unroll") for (int k = 0; k < 2; ++k) \
        acc[ai][bj][m][n] = __builtin_amdgcn_mfma_f32_16x16x32_bf16(Bt[n][k], At[m][k], acc[ai][bj][m][n], 0, 0, 0); __builtin_amdgcn_s_setprio(0); } while (0)
#define PG8_WAIT_V(n) asm volatile("s_waitcnt vmcnt(" #n ")" ::: "memory")
#define PG8_WAIT_L(n) asm volatile("s_waitcnt lgkmcnt(" #n ")" ::: "memory")
#define PG8_BAR __builtin_amdgcn_s_barrier()
#define PG8_SCHED __builtin_amdgcn_sched_barrier(0)
    Unit cur, nxt; int ui = 0;
    if (!S.next(0, cur)) return;
    f32x4 acc[2][2][4][2];
#pragma unroll
    for (int a = 0; a < 2; ++a)
#pragma unroll
        for (int b = 0; b < 2; ++b)
#pragma unroll
            for (int m = 0; m < 4; ++m)
#pragma unroll
                for (int n = 0; n < 2; ++n) acc[a][b][m][n] = (f32x4){0.f, 0.f, 0.f, 0.f};
    bf16x8 At[4][2], B0[2][2], B1[2][2];
    const char* cA = (const char*)g.A + (size_t)cur.pm * tstep; const char* cB = (const char*)g.Bt + (size_t)cur.pn * tstep;
    S.a_ready(cur);
    if constexpr (SP2) {
        PG8_STAGE(PG8_SB(0, 0), cB, voffB); PG8_STAGE(PG8_SB(0, 1), cB + hstep, voffB); PG8_STAGE(PG8_SA(0, 0), cA, voffA); PG8_STAGE(PG8_SA(0, 1), cA + hstep, voffA);
        if (wr == 1) PG8_BAR;
        PG8_WAIT_V(2); PG8_BAR;
        PG8_STAGE(PG8_SB(1, 0), cB + kstep, voffB); PG8_STAGE(PG8_SA(1, 0), cA + kstep, voffA); PG8_STAGE(PG8_SB(1, 1), cB + hstep + kstep, voffB);
        PG8_WAIT_V(6); PG8_BAR;
    } else {
        PG8_STAGE(PG8_SB(0, 0), cB, voffB); PG8_STAGE(PG8_SA(0, 0), cA, voffA); PG8_STAGE(PG8_SB(0, 1), cB + hstep, voffB); PG8_STAGE(PG8_SA(0, 1), cA + hstep, voffA);
        if (wr == 1) PG8_BAR;
        PG8_WAIT_V(4); PG8_BAR;
        PG8_STAGE(PG8_SB(1, 0), cB + kstep, voffB); PG8_STAGE(PG8_SA(1, 0), cA + kstep, voffA); PG8_STAGE(PG8_SB(1, 1), cB + hstep + kstep, voffB);
        PG8_WAIT_V(6); PG8_BAR;
    }
    for (;;) {
        const bool has_next = S.next(ui + 1, nxt);
        const char* nA = has_next ? (const char*)g.A + (size_t)nxt.pm * tstep : cA; const char* nB = has_next ? (const char*)g.Bt + (size_t)nxt.pn * tstep : cB;
        for (int t = 0; t < nt; t += 2) {
            const bool last = (t == nt - 2);
            const char* a1 = cA + (size_t)(t + 1) * kstep;
            const char* a2 = last ? nA : cA + (size_t)(t + 2) * kstep; const char* b2 = last ? nB : cB + (size_t)(t + 2) * kstep;
            const char* a3 = a2 + kstep; const char* b3 = b2 + kstep;
            if (last && has_next) S.a_ready(nxt);
            if constexpr (SP2) {
            PG8_LDB(B0, 0, 0); PG8_LDB(B1, 0, 1); PG8_SCHED; PG8_LDA(At, 0, 0); PG8_STAGE(PG8_SA(1, 1), a1 + hstep, voffA);
            PG8_WAIT_V(8); PG8_WAIT_L(0); PG8_BAR; PG8_MMA(0, 0, At, B0); PG8_MMA(0, 1, At, B1); PG8_BAR; PG8_SCHED;
            PG8_LDA(At, 0, 1); PG8_STAGE(PG8_SB(0, 0), b2, voffB); PG8_STAGE(PG8_SB(0, 1), b2 + hstep, voffB); PG8_STAGE(PG8_SA(0, 0), a2, voffA);
            PG8_WAIT_V(8); PG8_WAIT_L(0); PG8_BAR; PG8_MMA(1, 0, At, B0); PG8_MMA(1, 1, At, B1); PG8_BAR; PG8_SCHED;
            PG8_LDB(B0, 1, 0); PG8_LDB(B1, 1, 1); PG8_SCHED; PG8_LDA(At, 1, 0); PG8_STAGE(PG8_SA(0, 1), a2 + hstep, voffA);
            PG8_WAIT_V(8); PG8_WAIT_L(0); PG8_BAR; PG8_MMA(0, 0, At, B0); PG8_MMA(0, 1, At, B1); PG8_BAR; PG8_SCHED;
            PG8_LDA(At, 1, 1); PG8_STAGE(PG8_SB(1, 0), b3, voffB); PG8_STAGE(PG8_SB(1, 1), b3 + hstep, voffB); PG8_STAGE(PG8_SA(1, 0), a3, voffA);
            PG8_WAIT_V(8); PG8_WAIT_L(0); PG8_BAR; PG8_MMA(1, 0, At, B0); PG8_MMA(1, 1, At, B1); PG8_BAR; PG8_SCHED;
            } else {
            PG8_LDB(B0, 0, 0); PG8_SCHED; PG8_LDA(At, 0, 0); PG8_STAGE(PG8_SA(1, 1), a1 + hstep, voffA);
            PG8_WAIT_L(8); PG8_BAR; PG8_WAIT_L(0); PG8_MMA(0, 0, At, B0); PG8_BAR; PG8_SCHED;
            PG8_LDB(B1, 0, 1); PG8_STAGE(PG8_SB(0, 0), b2, voffB);
            PG8_BAR; PG8_WAIT_L(0); PG8_MMA(0, 1, At, B1); PG8_BAR;
            PG8_LDA(At, 0, 1); PG8_STAGE(PG8_SA(0, 0), a2, voffA);
            PG8_BAR; PG8_WAIT_L(0); PG8_MMA(1, 0, At, B0); PG8_BAR; PG8_SCHED;
            PG8_STAGE(PG8_SB(0, 1), b2 + hstep, voffB);
            PG8_WAIT_V(6); PG8_BAR; PG8_MMA(1, 1, At, B1); PG8_BAR;
            PG8_LDB(B0, 1, 0); PG8_SCHED; PG8_LDA(At, 1, 0); PG8_STAGE(PG8_SA(0, 1), a2 + hstep, voffA);
            PG8_WAIT_L(8); PG8_BAR; PG8_WAIT_L(0); PG8_MMA(0, 0, At, B0); PG8_BAR; PG8_SCHED;
            PG8_LDB(B1, 1, 1); PG8_STAGE(PG8_SB(1, 0), b3, voffB);
            PG8_BAR; PG8_WAIT_L(0); PG8_MMA(0, 1, At, B1); PG8_BAR;
            PG8_LDA(At, 1, 1); PG8_STAGE(PG8_SA(1, 0), a3, voffA);
            PG8_BAR; PG8_WAIT_L(0); PG8_MMA(1, 0, At, B0); PG8_BAR; PG8_SCHED;
            PG8_STAGE(PG8_SB(1, 1), b3 + hstep, voffB);
            PG8_WAIT_V(6); PG8_BAR; PG8_MMA(1, 1, At, B1); PG8_BAR;
            }
        }
        if constexpr (ALIGN_EPI) { if (wr == 0) PG8_BAR; }
        if constexpr (!Epi::AFTER_DRAIN) { E(acc, cur, wr, wc, fr, fq); S.done(cur); }
        if (!has_next) break;
#pragma unroll
        for (int a = 0; a < 2; ++a)
#pragma unroll
            for (int b = 0; b < 2; ++b)
#pragma unroll
                for (int m = 0; m < 4; ++m)
#pragma unroll
                    for (int n = 0; n < 2; ++n) acc[a][b][m][n] = (f32x4){0.f, 0.f, 0.f, 0.f};
        cur = nxt; cA = nA; cB = nB; ++ui;
        if constexpr (ALIGN_EPI) { if (wr == 1) PG8_BAR; }
    }
    PG8_WAIT_V(0);
    if constexpr (!ALIGN_EPI) { if (wr == 0) PG8_BAR; }
    PG8_BAR;
    if constexpr (Epi::AFTER_DRAIN) { E.fused(acc, cur, wr, wc, fr, fq, lds, wid, lane); S.done(cur); }
#undef PG8_SA
#undef PG8_SB
#undef PG8_STAGE
#undef PG8_LDA
#undef PG8_LDB
#undef PG8_MMA
#undef PG8_WAIT_V
#undef PG8_WAIT_L
#undef PG8_BAR
#undef PG8_SCHED
}
}

constexpr int BATCH = 2, SEQ = 8192, M = BATCH * SEQ, D = 2048;
constexpr int NIN = 6672, NINP = 6912, DFF = 5632, NGU = 2 * DFF;
constexpr int C_Q = 0, C_F = 1024, C_I = 2048, C_G = 3072, C_Z = 4096, C_XBC = 5120, C_DT = 6656;
constexpr int XBC_W = 1536;
constexpr float EPS = 1e-6f;
constexpr size_t MiB = 1u << 20;
constexpr size_t WS_CTL = 0, CTL_ZERO_BYTES = 65536;
constexpr size_t WS_LB = 65536;
constexpr size_t WS_WIN = 1 * MiB;
constexpr size_t WS_WOUT = 28 * MiB;
constexpr size_t WS_WGU = 36 * MiB;
constexpr size_t WS_WDN = 80 * MiB;
constexpr size_t WS_XN = 102 * MiB;
constexpr size_t WS_PROJ = 166 * MiB;
constexpr size_t WS_ST = 382 * MiB;
constexpr size_t WS_DEC = 478 * MiB;
constexpr size_t WS_X1B = 446 * MiB;
constexpr size_t WS_END = 510 * MiB;
constexpr int LDS_BYTES = 147456;

#define LAS __attribute__((address_space(3)))
typedef unsigned short bf16;
typedef float f32x4 __attribute__((ext_vector_type(4)));
typedef unsigned u32x4 __attribute__((ext_vector_type(4)));
#define LDS_WAIT() asm volatile("s_waitcnt lgkmcnt(0)" ::: "memory")
__device__ __forceinline__ float bf2f(unsigned short u) { return __uint_as_float(((unsigned)u) << 16); }
__device__ __forceinline__ unsigned f2bf(float f) { unsigned u = __float_as_uint(f); return (u + 0x7fffu + ((u >> 16) & 1u)) >> 16; }
__device__ __forceinline__ unsigned pk2(float lo, float hi) { return f2bf(lo) | (f2bf(hi) << 16); }
__device__ __forceinline__ float bflo(unsigned w) { return __uint_as_float(w << 16); }
__device__ __forceinline__ float bfhi(unsigned w) { return __uint_as_float(w & 0xffff0000u); }
__device__ __forceinline__ float wave_sum(float v) {
#pragma unroll
    for (int o = 1; o < 64; o <<= 1) v += __shfl_xor(v, o);
    return v;
}
__device__ __forceinline__ float sigm(float x) { return 1.0f / (1.0f + __expf(-x)); }
__device__ __forceinline__ float silu(float x) { return x / (1.0f + __expf(-x)); }

struct Params {
    const float *x, *pre_mix_w, *w_in, *lb_logits, *conv_w, *conv_b, *dt_bias, *a_log, *d_skip, *hgrn_nw, *ssd_nw, *w_out, *post_mix_w, *pre_ffn_w, *w_gate, *w_up, *w_down, *post_ffn_w;
    float* out; unsigned char* ws;
};

__device__ __forceinline__ void transpose_item(const float* W, int K, int N, bf16* WT, int k0, int n0, int rowb, LAS float* scr, int lane) {
    const int n_in = n0 + (lane & 31);
#pragma unroll 8
    for (int i = 0; i < 32; ++i) { const int kk = 2 * i + (lane >> 5); scr[kk * 33 + (lane & 31)] = (n_in < N) ? W[(size_t)(k0 + kk) * N + n_in] : 0.f; }
    LDS_WAIT();
    const int c = lane & 7;
#pragma unroll
    for (int j = 0; j < 4; ++j) { const int n = (lane >> 3) + 8 * j; const LAS float* s = scr + (8 * c) * 33 + n;
        u32x4 o; o.x = pk2(s[0 * 33], s[1 * 33]); o.y = pk2(s[2 * 33], s[3 * 33]); o.z = pk2(s[4 * 33], s[5 * 33]); o.w = pk2(s[6 * 33], s[7 * 33]);
        *(u32x4*)(WT + (size_t)(rowb + n) * K + k0 + 8 * c) = o; }
    LDS_WAIT();
}
__device__ __forceinline__ void rms_row_to_bf16(const float* xrow, const float* w, bf16* orow, int lane) {
    f32x4 v[8]; float ss = 0.f;
#pragma unroll
    for (int j = 0; j < 4; ++j) { const int base = 8 * (lane + 64 * j); v[2 * j] = *(const f32x4*)(xrow + base); v[2 * j + 1] = *(const f32x4*)(xrow + base + 4);
        const f32x4 a = v[2 * j], b = v[2 * j + 1]; ss += (a.x * a.x + a.y * a.y) + (a.z * a.z + a.w * a.w) + (b.x * b.x + b.y * b.y) + (b.z * b.z + b.w * b.w); }
    const float r = rsqrtf(wave_sum(ss) * (1.0f / D) + EPS);
#pragma unroll
    for (int j = 0; j < 4; ++j) { const int base = 8 * (lane + 64 * j); const f32x4 w0 = *(const f32x4*)(w + base), w1 = *(const f32x4*)(w + base + 4); const f32x4 a = v[2 * j], b = v[2 * j + 1];
        u32x4 o; o.x = pk2(a.x * r * w0.x, a.y * r * w0.y); o.y = pk2(a.z * r * w0.z, a.w * r * w0.w); o.z = pk2(b.x * r * w1.x, b.y * r * w1.y); o.w = pk2(b.z * r * w1.z, b.w * r * w1.w);
        *(u32x4*)(orow + base) = o; }
}

#define XB_TMO      128
#define XB_XCNT(j)  (256  + 64 * (j))
#define XB_XSUB(j)  (1280 + 64 * (j))
#define XB_XGEN(j)  (2304 + 64 * (j))
#define XB_TOP      3328
#define XB_TOPGEN   3392
#define XCD_BAR_WORDS 3456
#define XB_SPIN_CAP (1u << 18)

__device__ __forceinline__ unsigned xb_ld(unsigned* p)              { return __hip_atomic_load(p, __ATOMIC_RELAXED, __HIP_MEMORY_SCOPE_AGENT); }
__device__ __forceinline__ unsigned xb_add(unsigned* p, unsigned v) { return __hip_atomic_fetch_add(p, v, __ATOMIC_RELAXED, __HIP_MEMORY_SCOPE_AGENT); }
__device__ __forceinline__ unsigned xb_xcc_id() { return (unsigned)__builtin_amdgcn_s_getreg((3 << 11) | 20) & 0xFu; }
#define XB_SPIN(cond, bar) do { unsigned _sp = 0; while (cond) { __builtin_amdgcn_s_sleep(1); \
    if ((++_sp & 255u) == 0u) { if (xb_ld(&(bar)[XB_TMO])) break; if (_sp > XB_SPIN_CAP) { atomicAdd(&(bar)[XB_TMO], 1u); break; } } } } while (0)

struct XcdBarrier {
    unsigned* bar; unsigned x;
    volatile LAS unsigned* st;
};

__device__ __forceinline__ XcdBarrier xcd_barrier_post(unsigned* bar, volatile LAS unsigned* st) {
    XcdBarrier b; b.bar = bar; b.x = xb_xcc_id(); b.st = st;
    if (threadIdx.x == 0) (void)xb_add(&bar[XB_XCNT(b.x)], 1u);
    return b;
}
__device__ __forceinline__ void xcd_barrier_complete(unsigned* bar, unsigned x, unsigned& nloc, unsigned& nx) {
    const unsigned G = gridDim.x * gridDim.y * gridDim.z;
    unsigned sum, cnt, mine, sp = 0u;
    for (;;) {
        sum = 0u; cnt = 0u; mine = 0u;
#pragma unroll
        for (unsigned j = 0; j < 16; ++j) { const unsigned c = xb_ld(&bar[XB_XCNT(j)]); sum += c; cnt += (c > 0u) ? 1u : 0u; mine = (j == x) ? c : mine; }
        if (sum == G) break;
        __builtin_amdgcn_s_sleep(1);
        if ((++sp & 255u) == 0u) { if (xb_ld(&bar[XB_TMO])) break; if (sp > XB_SPIN_CAP) { atomicAdd(&bar[XB_TMO], 1u); break; } }
    }
    nloc = mine > 0u ? mine : 1u; nx = cnt > 0u ? cnt : 1u;
}

__device__ __forceinline__ void xcd_barrier(const XcdBarrier& b) {
    asm volatile("s_waitcnt vmcnt(0)" ::: "memory");
    __syncthreads();
    if (threadIdx.x == 0) {
        unsigned* bar = b.bar;
        __builtin_amdgcn_s_waitcnt(0);
        unsigned nloc = b.st[0], nx = b.st[1];
        if (nloc == 0u) { xcd_barrier_complete(bar, b.x, nloc, nx); b.st[0] = nloc; b.st[1] = nx; }
        const unsigned old = xb_add(&bar[XB_XSUB(b.x)], 1u);
        const unsigned gen = old / nloc;
        if (old + 1u == (gen + 1u) * nloc) {
            __builtin_amdgcn_fence(__ATOMIC_RELEASE, "agent");
            asm volatile("s_waitcnt vmcnt(0)" ::: "memory");
            const unsigned og = xb_add(&bar[XB_TOP], 1u);
            const unsigned tg = og / nx;
            if (og + 1u == (tg + 1u) * nx) xb_add(&bar[XB_TOPGEN], 1u);
            else XB_SPIN(xb_ld(&bar[XB_TOPGEN]) == tg, bar);
            __builtin_amdgcn_fence(__ATOMIC_ACQUIRE, "agent");
            xb_add(&bar[XB_XGEN(b.x)], 1u);
            asm volatile("s_waitcnt vmcnt(0)" ::: "memory");
        } else {
            XB_SPIN(xb_ld(&bar[XB_XGEN(b.x)]) == gen, bar);
            __builtin_amdgcn_fence(__ATOMIC_ACQUIRE, "agent");
            asm volatile("s_waitcnt vmcnt(0)" ::: "memory");
        }
    }
    __syncthreads();
}
constexpr size_t WS_ST_S = WS_ST + 64 * MiB;
constexpr size_t WS_DEC_S = WS_DEC + 1 * MiB;
typedef short bf16x8 __attribute__((ext_vector_type(8)));
typedef unsigned u32x2 __attribute__((ext_vector_type(2)));
#define LBAR() do { asm volatile("s_waitcnt lgkmcnt(0)" ::: "memory"); __builtin_amdgcn_s_barrier(); asm volatile("" ::: "memory"); } while (0)
#define G16(base, eoff) (*(const u32x4*)((const bf16*)(base) + (unsigned)(eoff)))
#define G2(base, eoff) (((const bf16*)(base))[(unsigned)(eoff)])
__device__ __forceinline__ f32x4 mma_lds(const LAS bf16* A, int lda, const LAS bf16* Bt, int ldb, int K, f32x4 acc, int lane) {
    const int r = lane & 15, q = lane >> 4;
    for (int k0 = 0; k0 < K; k0 += 32) {
        const bf16x8 a = *(const LAS bf16x8*)(A + r * lda + k0 + 8 * q);
        const bf16x8 b = *(const LAS bf16x8*)(Bt + r * ldb + k0 + 8 * q);
        acc = __builtin_amdgcn_mfma_f32_16x16x32_bf16(a, b, acc, 0, 0, 0);
    }
    return acc;
}

template <bool OUT>
__device__ __forceinline__ void hgrn_unit(LAS unsigned char* lds, const Params& p, int u) {
    const int tid = threadIdx.x, lane = tid & 63, wave = __builtin_amdgcn_readfirstlane(tid >> 6), I = wave >> 1, k = tid & 127, r = lane & 15, q = lane >> 4;
    const int b = u >> 10, c = (u >> 3) & 127, h = u & 7;
    const unsigned row0 = (unsigned)(b * SEQ + c * 64), rowb = row0 * NINP;
    const bf16* proj = (const bf16*)(p.ws + WS_PROJ);
    const int uh = (b * 8 + h) * 128 + c;
    bf16* STb = (bf16*)(p.ws + WS_ST); const unsigned so = (unsigned)uh * 16384u;
    LAS float* Tsum = (LAS float*)lds;
    LAS bf16* vT = (LAS bf16*)(lds + 2048);
    LAS bf16* KdT = (LAS bf16*)(lds + 20480);
    LAS bf16* Qt = (LAS bf16*)(lds + 20480);
    LAS bf16* Qb = Qt + 64 * 136;
    LAS bf16* KT = Qb + 64 * 136;
    LAS bf16* P = KT + 160 * 136;
    LAS float* red = (LAS float*)(P + 64 * 72);
    LAS bf16* Sl = (LAS bf16*)(lds + 108544);
    const int rt = wave >> 1;
    u32x4 Sreg[4]; unsigned short greg[16];
    if (OUT) {
#pragma unroll
        for (int i = 0; i < 4; ++i) { const int e = tid + 512 * i; Sreg[i] = G16(STb, so + (e >> 4) * 128 + 8 * (e & 15)); }
#pragma unroll
        for (int j = 0; j < 4; ++j)
#pragma unroll
            for (int c4 = 0; c4 < 4; ++c4) greg[j * 4 + c4] = G2(proj, rowb + (16 * rt + 4 * q + j) * NINP + C_G + h * 128 + 16 * (4 * (wave & 1) + c4) + r);
    }
    float bl[16], kk[16], qv[16];
    {
        const unsigned po = rowb + 16 * I * NINP + h * 128 + k; float run = 0.f;
        unsigned short fraw[16], qraw[16];
#pragma unroll
        for (int j = 0; j < 16; ++j) { fraw[j] = G2(proj, po + j * NINP + C_F); qraw[j] = OUT ? G2(proj, po + j * NINP + C_Q) : (unsigned short)0; }
        unsigned w[8];
#pragma unroll
        for (int j2 = 0; j2 < 8; ++j2) w[j2] = (unsigned)G2(proj, po + C_I + (2 * j2) * NINP) | ((unsigned)G2(proj, po + C_I + (2 * j2 + 1) * NINP) << 16);
#pragma unroll
        for (int j = 0; j < 16; ++j) { const float gl = bf2f(fraw[j]); run += gl; bl[j] = run; kk[j] = 1.0f - __expf(gl); qv[j] = bf2f(qraw[j]); }
        Tsum[I * 128 + k] = run;
        LAS u32x4* dst = (LAS u32x4*)(vT + k * 72 + 16 * I); dst[0] = (u32x4){w[0], w[1], w[2], w[3]}; dst[1] = (u32x4){w[4], w[5], w[6], w[7]};
    }
    LBAR();
    const float T0 = Tsum[k], T1 = Tsum[128 + k], T2 = Tsum[256 + k], T3 = Tsum[384 + k];
    const float start = (I > 0 ? T0 : 0.f) + (I > 1 ? T1 : 0.f) + (I > 2 ? T2 : 0.f), btot = (T0 + T1) + (T2 + T3);
    if (!OUT) {
        unsigned w[8]; const float e0 = btot - start;
#pragma unroll
        for (int j2 = 0; j2 < 8; ++j2) w[j2] = pk2(kk[2 * j2] * __expf(e0 - bl[2 * j2]), kk[2 * j2 + 1] * __expf(e0 - bl[2 * j2 + 1]));
        LAS u32x4* dst = (LAS u32x4*)(KdT + k * 72 + 16 * I); dst[0] = (u32x4){w[0], w[1], w[2], w[3]}; dst[1] = (u32x4){w[4], w[5], w[6], w[7]};
        if (I == 0) ((float*)(p.ws + WS_DEC))[(size_t)uh * 128 + k] = __expf(btot);
        LBAR();
#pragma unroll
        for (int n = 0; n < 8; ++n) {
            const f32x4 acc = mma_lds(KdT + 16 * wave * 72, 72, vT + 16 * n * 72, 72, 64, (f32x4){0.f, 0.f, 0.f, 0.f}, lane);
            *(u32x2*)(STb + (unsigned)(so + (16 * n + r) * 128 + 16 * wave + 4 * q)) = (u32x2){pk2(acc[0], acc[1]), pk2(acc[2], acc[3])};
        }
        LBAR();
        return;
    }
    {
        const float es = __expf(start);
#pragma unroll
        for (int j = 0; j < 16; ++j) { const int t = 16 * I + j; const float e1 = qv[j] * __expf(bl[j]); Qt[t * 136 + k] = (bf16)f2bf(e1); Qb[t * 136 + k] = (bf16)f2bf(e1 * es); }
        float Dacc = 0.f;
#pragma unroll
        for (int I2 = 0; I2 < 4; ++I2) {
            if (I2 >= I) { const int pair = I2 * (I2 + 1) / 2 + I;
#pragma unroll
                for (int j = 0; j < 16; ++j) KT[(pair * 16 + j) * 136 + k] = (bf16)f2bf(kk[j] * __expf(Dacc - bl[j]));
                Dacc += (I2 == 0 ? T0 : I2 == 1 ? T1 : I2 == 2 ? T2 : T3); }
        }
#pragma unroll
        for (int i = 0; i < 4; ++i) { const int e = tid + 512 * i; *(LAS u32x4*)(Sl + (e >> 4) * 136 + 8 * (e & 15)) = Sreg[i]; }
    }
    LBAR();
    {
        const int I2 = wave >> 1;
#pragma unroll
        for (int jj = 0; jj < 2; ++jj) { const int J = 2 * (wave & 1) + jj; f32x4 sc = (f32x4){0.f, 0.f, 0.f, 0.f};
            if (J <= I2) { const int pair = I2 * (I2 + 1) / 2 + J; sc = mma_lds(Qt + 16 * I2 * 136, 136, KT + pair * 16 * 136, 136, 128, sc, lane);
                if (J == I2) {
#pragma unroll
                    for (int j = 0; j < 4; ++j) if (r > 4 * q + j) sc[j] = 0.f; } }
#pragma unroll
            for (int j = 0; j < 4; ++j) P[(16 * I2 + 4 * q + j) * 72 + 16 * J + r] = (bf16)f2bf(sc[j]); }
    }
    LBAR();
    {
        f32x4 o[4]; float ssq[4] = {0.f, 0.f, 0.f, 0.f};
#pragma unroll
        for (int c4 = 0; c4 < 4; ++c4) { const int n = 4 * (wave & 1) + c4;
            f32x4 acc = mma_lds(P + 16 * rt * 72, 72, vT + 16 * n * 72, 72, 64, (f32x4){0.f, 0.f, 0.f, 0.f}, lane);
            acc = mma_lds(Qb + 16 * rt * 136, 136, Sl + 16 * n * 136, 136, 128, acc, lane);
            o[c4] = acc;
#pragma unroll
            for (int j = 0; j < 4; ++j) ssq[j] += acc[j] * acc[j]; }
#pragma unroll
        for (int j = 0; j < 4; ++j) { float s = ssq[j]; s += __shfl_xor(s, 1); s += __shfl_xor(s, 2); s += __shfl_xor(s, 4); s += __shfl_xor(s, 8); if (r == 0) red[(16 * rt + 4 * q + j) * 2 + (wave & 1)] = s; }
        LBAR();
        bf16* mixin = (bf16*)(p.ws + WS_XN);
#pragma unroll
        for (int j = 0; j < 4; ++j) { const int t = 16 * rt + 4 * q + j; const float rs = rsqrtf((red[t * 2] + red[t * 2 + 1]) * (1.0f / 128.0f) + EPS);
#pragma unroll
            for (int c4 = 0; c4 < 4; ++c4) { const int v = 16 * (4 * (wave & 1) + c4) + r;
                mixin[(unsigned)((row0 + t) * 2048 + h * 128 + v)] = (bf16)f2bf(o[c4][j] * rs * p.hgrn_nw[h * 128 + v] * bf2f(greg[j * 4 + c4])); } }
    }
    LBAR();
}

template <bool OUT>
__device__ __forceinline__ void ssd_unit(LAS unsigned char* lds, const Params& p, int u) {
    const int tid = threadIdx.x, lane = tid & 63, wave = __builtin_amdgcn_readfirstlane(tid >> 6), r = lane & 15, q = lane >> 4;
    const int b = u >> 7, c = (u >> 1) & 63, g = u & 1;
    const unsigned row0 = (unsigned)(b * SEQ + c * 128), rowb = row0 * NINP;
    const bool first = (c == 0);
    const bf16* proj = (const bf16*)(p.ws + WS_PROJ); bf16* mixin = (bf16*)(p.ws + WS_XN);
    LAS float* acs = (LAS float*)lds;
    LAS float* dtl = acs + 1024;
    LAS bf16* Cn = (LAS bf16*)(lds + 8192);
    LAS bf16* Bn = Cn + 128 * 136;
    LAS bf16* xT = Bn + 128 * 136;
    LAS bf16* xsN = xT + 64 * 136;
    LAS float* red = (LAS float*)(xsN + 128 * 72);
    LAS bf16* PV = (LAS bf16*)(lds + 114176);
    LAS bf16* hal = PV + 64 * 136;
    const int headw = g * 8 + wave;
    const float d0 = bf2f(G2(proj, rowb + lane * NINP + C_DT + headw)), d1 = bf2f(G2(proj, rowb + (64 + lane) * NINP + C_DT + headw));
    u32x4 braw[OUT ? 8 : 4];
#pragma unroll
    for (int i = 0; i < (OUT ? 8 : 4); ++i) { const int e = tid + 512 * i, which = e >> 11, e2 = e & 2047;
        braw[i] = G16(proj, rowb + (e2 >> 4) * NINP + C_XBC + 1024 + which * 256 + g * 128 + 8 * (e2 & 15)); }
    const int cch = tid & 127, cwhich = (tid >> 7) & 1, cseg = tid >> 8, ccol = 1024 + cwhich * 256 + g * 128 + cch;
    const bool cact = OUT || cwhich == 0;
    float r0 = 0.f, r1 = 0.f, r2 = 0.f;
    if (cact && cseg == 0 && !first) { const unsigned o = rowb + C_XBC + ccol; r0 = bf2f(G2(proj, o - 3 * NINP)); r1 = bf2f(G2(proj, o - 2 * NINP)); r2 = bf2f(G2(proj, o - NINP)); }
    {
        const float A = -expf(p.a_log[headw]);
        float a0 = d0 * A, a1 = d1 * A;
#pragma unroll
        for (int o = 1; o < 64; o <<= 1) { const float t0 = __shfl_up(a0, o), t1 = __shfl_up(a1, o); if (lane >= o) { a0 += t0; a1 += t1; } }
        a1 += __shfl(a0, 63);
        acs[wave * 128 + lane] = a0; acs[wave * 128 + 64 + lane] = a1; dtl[wave * 128 + lane] = d0; dtl[wave * 128 + 64 + lane] = d1;
        if (!OUT && lane == 63) ((float*)(p.ws + WS_DEC_S))[(b * 16 + headw) * 64 + c] = __expf(a1);
#pragma unroll
        for (int i = 0; i < (OUT ? 8 : 4); ++i) { const int e = tid + 512 * i, which = e >> 11, e2 = e & 2047;
            *(LAS u32x4*)((which ? Cn : Bn) + (e2 >> 4) * 136 + 8 * (e2 & 15)) = braw[i]; }
    }
    LBAR();
    LAS bf16* csrc = cwhich ? Cn : Bn;
    if (cact && cseg == 1) { r0 = bf2f(csrc[61 * 136 + cch]); r1 = bf2f(csrc[62 * 136 + cch]); r2 = bf2f(csrc[63 * 136 + cch]); }
    LBAR();
    if (cact) {
        const float w0 = p.conv_w[ccol], w1 = p.conv_w[XBC_W + ccol], w2 = p.conv_w[2 * XBC_W + ccol], w3 = p.conv_w[3 * XBC_W + ccol], bias = p.conv_b[ccol];
        const int tb = 64 * cseg;
#pragma unroll 8
        for (int i = 0; i < 64; ++i) { const float r3 = bf2f(csrc[(tb + i) * 136 + cch]); const float val = silu(bias + w0 * r0 + w1 * r1 + w2 * r2 + w3 * r3); r0 = r1; r1 = r2; r2 = r3;
            if (OUT) csrc[(tb + i) * 136 + cch] = (bf16)f2bf(val); else Cn[cch * 136 + tb + i] = (bf16)f2bf(val); }
    }
    LBAR();
    f32x4 cb[8];
    if (OUT) {
#pragma unroll
        for (int n8 = 0; n8 < 8; ++n8) cb[n8] = mma_lds(Cn + 16 * wave * 136, 136, Bn + 16 * n8 * 136, 136, 128, (f32x4){0.f, 0.f, 0.f, 0.f}, lane);
        LBAR();
    }
    float ssq[4] = {0.f, 0.f, 0.f, 0.f};
    float dmask[4];
#pragma unroll
    for (int j = 0; j < 4; ++j) dmask[j] = (r <= 4 * q + j) ? 1.0f : 0.0f;
    const int pp = tid & 63, xseg = tid >> 6, xtb = 16 * xseg;
    for (int hh = 0; hh < 8; ++hh) {
        const int head = g * 8 + hh, xcol = g * 512 + hh * 64;
        const bf16* stS = (const bf16*)(p.ws + WS_ST_S); const unsigned so = (unsigned)((b * 16 + head) * 64 + c) * 8192u;
        u32x4 xraw[2], pvr[2]; unsigned short zreg[16]; unsigned short hraw = 0;
#pragma unroll
        for (int i = 0; i < 2; ++i) { const int e = tid + 512 * i; xraw[i] = G16(proj, rowb + (e >> 3) * NINP + C_XBC + xcol + 8 * (e & 7)); }
        if (tid < 192 && !first) hraw = G2(proj, rowb - (3 - (tid >> 6)) * NINP + C_XBC + xcol + pp);
        if (OUT) {
#pragma unroll
            for (int i = 0; i < 2; ++i) { const int e = tid + 512 * i; pvr[i] = G16(stS, so + (e >> 4) * 128 + 8 * (e & 15)); }
        }
#pragma unroll
        for (int i = 0; i < 2; ++i) { const int e = tid + 512 * i; *(LAS u32x4*)(xsN + (e >> 3) * 72 + 8 * (e & 7)) = xraw[i]; }
        if (tid < 192) hal[tid] = hraw;
        if (OUT) {
#pragma unroll
            for (int i = 0; i < 2; ++i) { const int e = tid + 512 * i; *(LAS u32x4*)(PV + (e >> 4) * 136 + 8 * (e & 15)) = pvr[i]; }
        }
        LBAR();
        float x0, x1, x2;
        if (xseg == 0) { x0 = bf2f(hal[pp]); x1 = bf2f(hal[64 + pp]); x2 = bf2f(hal[128 + pp]); }
        else { x0 = bf2f(xsN[(xtb - 3) * 72 + pp]); x1 = bf2f(xsN[(xtb - 2) * 72 + pp]); x2 = bf2f(xsN[(xtb - 1) * 72 + pp]); }
        LBAR();
        {
            const int col = xcol + pp;
            const float w0 = p.conv_w[col], w1 = p.conv_w[XBC_W + col], w2 = p.conv_w[2 * XBC_W + col], w3 = p.conv_w[3 * XBC_W + col], bias = p.conv_b[col];
            const float alast = acs[hh * 128 + 127];
            unsigned w[8]; float prev = 0.f;
#pragma unroll
            for (int i = 0; i < 16; ++i) { const int s = xtb + i; const float x3 = bf2f(xsN[s * 72 + pp]); const float val = silu(bias + w0 * x0 + w1 * x1 + w2 * x2 + w3 * x3); x0 = x1; x1 = x2; x2 = x3;
                float xv = val * dtl[hh * 128 + s];
                if (OUT) xsN[s * 72 + pp] = (bf16)f2bf(val); else xv *= __expf(alast - acs[hh * 128 + s]);
                if (i & 1) w[i >> 1] = pk2(prev, xv); else prev = xv;
                if ((i & 3) == 3) __builtin_amdgcn_sched_barrier(0); }
            LAS u32x4* dst = (LAS u32x4*)(xT + pp * 136 + xtb); dst[0] = (u32x4){w[0], w[1], w[2], w[3]}; dst[1] = (u32x4){w[4], w[5], w[6], w[7]};
        }
        __builtin_amdgcn_sched_barrier(0);
        if (OUT) {
            LAS bf16* W = Bn;
#pragma unroll
            for (int n8 = 0; n8 < 8; ++n8)
#pragma unroll
                for (int j = 0; j < 4; ++j) { const int t = 16 * wave + 4 * q + j, s = 16 * n8 + r;
                    const float mk = (n8 < wave) ? 1.0f : ((n8 == wave) ? dmask[j] : 0.0f);
                    const float val = cb[n8][j] * __expf(fminf(acs[hh * 128 + t] - acs[hh * 128 + s], 0.f)) * mk; W[t * 136 + s] = (bf16)f2bf(val);
                    if (j == 3 && (n8 & 1)) __builtin_amdgcn_sched_barrier(0); }
        }
        LBAR();
        if (OUT) {
            const float Dk = p.d_skip[head];
#pragma unroll
            for (int c4 = 0; c4 < 4; ++c4) {
#pragma unroll
                for (int j = 0; j < 4; ++j) zreg[c4 * 4 + j] = G2(proj, rowb + (16 * wave + 4 * q + j) * NINP + C_Z + head * 64 + 16 * c4 + r);
                const f32x4 accd = mma_lds(Bn + 16 * wave * 136, 136, xT + 16 * c4 * 136, 136, 128, (f32x4){0.f, 0.f, 0.f, 0.f}, lane);
                __builtin_amdgcn_sched_barrier(0);
                const f32x4 acco = mma_lds(Cn + 16 * wave * 136, 136, PV + 16 * c4 * 136, 136, 128, (f32x4){0.f, 0.f, 0.f, 0.f}, lane);
#pragma unroll
                for (int j = 0; j < 4; ++j) { const int t = 16 * wave + 4 * q + j, pcol = 16 * c4 + r;
                    float y = accd[j] + __expf(acs[hh * 128 + t]) * acco[j] + Dk * bf2f(xsN[t * 72 + pcol]);
                    y *= bf2f(zreg[c4 * 4 + j]); ssq[j] += y * y;
                    mixin[(unsigned)((row0 + t) * 2048 + 1024 + xcol + pcol)] = (bf16)f2bf(y * p.ssd_nw[xcol + pcol]); }
                __builtin_amdgcn_sched_barrier(0);
            }
        } else {
            bf16* Lst = (bf16*)(p.ws + WS_ST_S);
#pragma unroll
            for (int c4 = 0; c4 < 4; ++c4) {
                const f32x4 acc = mma_lds(Cn + 16 * wave * 136, 136, xT + 16 * c4 * 136, 136, 128, (f32x4){0.f, 0.f, 0.f, 0.f}, lane);
                *(u32x2*)(Lst + (unsigned)(so + (16 * c4 + r) * 128 + 16 * wave + 4 * q)) = (u32x2){pk2(acc[0], acc[1]), pk2(acc[2], acc[3])};
            }
        }
        LBAR();
    }
    if (OUT) {
#pragma unroll
        for (int j = 0; j < 4; ++j) { float s = ssq[j]; s += __shfl_xor(s, 1); s += __shfl_xor(s, 2); s += __shfl_xor(s, 4); s += __shfl_xor(s, 8); if (r == 0) red[16 * wave + 4 * q + j] = rsqrtf(s * (1.0f / 512.0f) + EPS); }
        __syncthreads();
        for (int e = tid; e < 128 * 64; e += 512) { const int t = e >> 6, c8 = e & 63; const float rs = red[t];
            u32x4* ptr = (u32x4*)(mixin + (unsigned)((row0 + t) * 2048 + 1024 + g * 512 + 8 * c8)); u32x4 w = *ptr;
            w.x = pk2(bflo(w.x) * rs, bfhi(w.x) * rs); w.y = pk2(bflo(w.y) * rs, bfhi(w.y) * rs); w.z = pk2(bflo(w.z) * rs, bfhi(w.z) * rs); w.w = pk2(bflo(w.w) * rs, bfhi(w.w) * rs); *ptr = w; }
        LBAR();
    }
}

__device__ __forceinline__ void state_scan(const Params& p, int gt, int GT) {
    for (int e = gt; e < 131072; e += GT) {
        if (e < 65536) {
            const int bh = e >> 12, off4 = e & 4095;
            bf16* st = (bf16*)(p.ws + WS_ST) + (size_t)bh * 128 * 16384 + off4 * 4; const float* dec = (const float*)(p.ws + WS_DEC) + (size_t)bh * 128 * 128 + (off4 & 31) * 4;
            f32x4 S = (f32x4){0.f, 0.f, 0.f, 0.f};
            for (int c0 = 0; c0 < 128; c0 += 8) {
                u32x2 L[8]; f32x4 d[8];
#pragma unroll
                for (int i = 0; i < 8; ++i) { L[i] = *(const u32x2*)(st + (size_t)(c0 + i) * 16384); d[i] = *(const f32x4*)(dec + (c0 + i) * 128); }
#pragma unroll
                for (int i = 0; i < 8; ++i) { *(u32x2*)(st + (size_t)(c0 + i) * 16384) = (u32x2){pk2(S.x, S.y), pk2(S.z, S.w)};
                    S.x = d[i].x * S.x + bflo(L[i].x); S.y = d[i].y * S.y + bfhi(L[i].x); S.z = d[i].z * S.z + bflo(L[i].y); S.w = d[i].w * S.w + bfhi(L[i].y); }
            }
        } else {
            const int e2 = e - 65536, bhd = e2 >> 11, off4 = e2 & 2047;
            bf16* st = (bf16*)(p.ws + WS_ST_S) + (size_t)bhd * 64 * 8192 + off4 * 4; const float* dec = (const float*)(p.ws + WS_DEC_S) + bhd * 64;
            f32x4 S = (f32x4){0.f, 0.f, 0.f, 0.f};
            for (int c0 = 0; c0 < 64; c0 += 8) {
                u32x2 L[8]; float d[8];
#pragma unroll
                for (int i = 0; i < 8; ++i) { L[i] = *(const u32x2*)(st + (size_t)(c0 + i) * 8192); d[i] = dec[c0 + i]; }
#pragma unroll
                for (int i = 0; i < 8; ++i) { *(u32x2*)(st + (size_t)(c0 + i) * 8192) = (u32x2){pk2(S.x, S.y), pk2(S.z, S.w)};
                    S.x = d[i] * S.x + bflo(L[i].x); S.y = d[i] * S.y + bfhi(L[i].x); S.z = d[i] * S.z + bflo(L[i].y); S.w = d[i] * S.w + bfhi(L[i].y); }
            }
        }
    }
}

#ifndef R_GEMM
#define R_GEMM 1
#endif
#ifndef R_P0
#define R_P0 1
#endif
#ifndef R_P4
#define R_P4 1
#endif
#ifndef R_MIXAS
#define R_MIXAS 1
#endif
#ifndef R_MIXAH
#define R_MIXAH 1
#endif
#ifndef R_MIXCH
#define R_MIXCH 1
#endif
#ifndef R_MIXCS
#define R_MIXCS 1
#endif
#ifndef R_MIXC
#define R_MIXC 1
#endif
#ifndef MIX_MODE
#define MIX_MODE 1
#endif
__global__ void __launch_bounds__(512) fwd_kernel(Params p) {
    extern __shared__ __attribute__((aligned(16))) unsigned char lds_raw[];
    LAS unsigned char* lds = (LAS unsigned char*)lds_raw;
    cg::grid_group grid = cg::this_grid();
    volatile LAS unsigned* bst = (volatile LAS unsigned*)(lds + LDS_BYTES - 64);
    if (threadIdx.x < 2) bst[threadIdx.x] = 0u;
    __syncthreads();
    const XcdBarrier xbar = xcd_barrier_post((unsigned*)(p.ws + WS_CTL), bst);
#define GSYNC() xcd_barrier(xbar)
    if (p.ws == nullptr) grid.sync();
    const int tid = threadIdx.x, lane = tid & 63, wave = __builtin_amdgcn_readfirstlane(tid >> 6);
    const int G = gridDim.x, gw = blockIdx.x * 8 + wave, NGW = G * 8;
    bf16* WIN = (bf16*)(p.ws + WS_WIN); bf16* WOUT = (bf16*)(p.ws + WS_WOUT); bf16* WGU = (bf16*)(p.ws + WS_WGU); bf16* WDN = (bf16*)(p.ws + WS_WDN);
    bf16* XN = (bf16*)(p.ws + WS_XN); bf16* PROJ = (bf16*)(p.ws + WS_PROJ); bf16* HID = (bf16*)(p.ws + WS_PROJ); bf16* MIXO = (bf16*)(p.ws + WS_ST); bf16* FF = (bf16*)(p.ws + WS_ST); bf16* X1B = (bf16*)(p.ws + WS_X1B);

    {
        LAS float* scr = (LAS float*)(lds + wave * 16384);
        constexpr int I_IN = 32 * (NINP / 32), I_OUT = 32 * (D / 32), I_G = 32 * (DFF / 32), I_DN = (DFF / 64) * (D / 32);
        constexpr int NITEMS = I_IN + I_OUT + 2 * I_G + I_DN;
        for (int it = gw; it < NITEMS * R_P0; it += NGW) {
            int r = it % NITEMS;
            if (r < I_IN) { const int nb = NINP / 32, kb = r / nb, n0 = 32 * (r % nb); transpose_item(p.w_in, D, NIN, WIN, 64 * kb, n0, n0, scr, lane); continue; } r -= I_IN;
            if (r < I_OUT) { const int nb = D / 32, kb = r / nb, n0 = 32 * (r % nb); transpose_item(p.w_out, D, D, WOUT, 64 * kb, n0, n0, scr, lane); continue; } r -= I_OUT;
            if (r < I_G) { const int nb = DFF / 32, kb = r / nb, n0 = 32 * (r % nb); transpose_item(p.w_gate, D, DFF, WGU, 64 * kb, n0, 256 * (n0 >> 7) + (n0 & 127), scr, lane); continue; } r -= I_G;
            if (r < I_G) { const int nb = DFF / 32, kb = r / nb, n0 = 32 * (r % nb); transpose_item(p.w_up, D, DFF, WGU, 64 * kb, n0, 256 * (n0 >> 7) + 128 + (n0 & 127), scr, lane); continue; } r -= I_G;
            { const int nb = D / 32, kb = r / nb, n0 = 32 * (r % nb); transpose_item(p.w_down, DFF, D, WDN, 64 * kb, n0, n0, scr, lane); }
        }
        if (blockIdx.x == 0) for (int i = tid; i < 1024; i += 512) ((float*)(p.ws + WS_LB))[i] = 1.0f / (1.0f + expf(p.lb_logits[1024 + i] - p.lb_logits[i]));
        for (int mm = gw; mm < M * R_P0; mm += NGW) { const int m = mm & (M - 1); rms_row_to_bf16(p.x + (size_t)m * D, p.pre_mix_w, XN + (size_t)m * D, lane); }
    }
    GSYNC();
    {
        pg8::Gemm g{XN, WIN, M, NINP, D}; pg8::StaticOrder S; S.init(M, NINP, G, (int)blockIdx.x, R_GEMM); pg8::EpiProj E{PROJ, NINP, (const float*)(p.ws + WS_LB), p.dt_bias};
        pg8::gemm_phase<pg8::EpiProj, pg8::StaticOrder, true, true>(lds, g, S, E);
    }
    GSYNC();
    if (MIX_MODE != 0) {
        for (int u = blockIdx.x; u < 256 * R_MIXAS; u += G) ssd_unit<false>(lds, p, u & 255);
        for (int u = blockIdx.x; u < 2048 * R_MIXAH; u += G) hgrn_unit<false>(lds, p, u & 2047);
        GSYNC();
        state_scan(p, (int)blockIdx.x * 512 + tid, G * 512);
        GSYNC();
        for (int u = blockIdx.x; u < 256 * R_MIXCS; u += G) ssd_unit<true>(lds, p, u & 255);
        for (int u = blockIdx.x; u < 2048 * R_MIXCH; u += G) hgrn_unit<true>(lds, p, u & 2047);
    }
    GSYNC();
    {
        pg8::Gemm g{XN, WOUT, M, D, D}; pg8::StaticOrder S; S.init(M, D, G, (int)blockIdx.x, R_GEMM); pg8::EpiBf16 E{MIXO, D};
        pg8::gemm_phase<pg8::EpiBf16, pg8::StaticOrder, true, true>(lds, g, S, E);
    }
    GSYNC();
    for (int mm = gw; mm < M * R_P4; mm += NGW) { const int m = mm & (M - 1);
        const float* xr = p.x + (size_t)m * D; const bf16* mr = MIXO + (size_t)m * D; bf16* x1row = X1B + (size_t)m * D; bf16* xn = XN + (size_t)m * D;
        u32x4 mw[4]; float ss = 0.f;
#pragma unroll
        for (int j = 0; j < 4; ++j) { mw[j] = *(const u32x4*)(mr + 8 * (lane + 64 * j));
            const float a0 = bflo(mw[j].x), a1 = bfhi(mw[j].x), a2 = bflo(mw[j].y), a3 = bfhi(mw[j].y), a4 = bflo(mw[j].z), a5 = bfhi(mw[j].z), a6 = bflo(mw[j].w), a7 = bfhi(mw[j].w);
            ss += (a0 * a0 + a1 * a1) + (a2 * a2 + a3 * a3) + (a4 * a4 + a5 * a5) + (a6 * a6 + a7 * a7); }
        const float r1 = rsqrtf(wave_sum(ss) * (1.0f / D) + EPS);
        f32x4 x1[8]; float ss1 = 0.f;
#pragma unroll
        for (int j = 0; j < 4; ++j) { const int base = 8 * (lane + 64 * j);
            const f32x4 xa = *(const f32x4*)(xr + base), xb = *(const f32x4*)(xr + base + 4), wa = *(const f32x4*)(p.post_mix_w + base), wb = *(const f32x4*)(p.post_mix_w + base + 4);
            f32x4 a, b2;
            a.x = xa.x + bflo(mw[j].x) * r1 * wa.x; a.y = xa.y + bfhi(mw[j].x) * r1 * wa.y; a.z = xa.z + bflo(mw[j].y) * r1 * wa.z; a.w = xa.w + bfhi(mw[j].y) * r1 * wa.w;
            b2.x = xb.x + bflo(mw[j].z) * r1 * wb.x; b2.y = xb.y + bfhi(mw[j].z) * r1 * wb.y; b2.z = xb.z + bflo(mw[j].w) * r1 * wb.z; b2.w = xb.w + bfhi(mw[j].w) * r1 * wb.w;
            x1[2 * j] = a; x1[2 * j + 1] = b2; { u32x4 o; o.x = pk2(a.x, a.y); o.y = pk2(a.z, a.w); o.z = pk2(b2.x, b2.y); o.w = pk2(b2.z, b2.w); *(u32x4*)(x1row + base) = o; }
            ss1 += (a.x * a.x + a.y * a.y) + (a.z * a.z + a.w * a.w) + (b2.x * b2.x + b2.y * b2.y) + (b2.z * b2.z + b2.w * b2.w); }
        const float r2 = rsqrtf(wave_sum(ss1) * (1.0f / D) + EPS);
#pragma unroll
        for (int j = 0; j < 4; ++j) { const int base = 8 * (lane + 64 * j); const f32x4 w0 = *(const f32x4*)(p.pre_ffn_w + base), w1 = *(const f32x4*)(p.pre_ffn_w + base + 4); const f32x4 a = x1[2 * j], b2 = x1[2 * j + 1];
            u32x4 o; o.x = pk2(a.x * r2 * w0.x, a.y * r2 * w0.y); o.y = pk2(a.z * r2 * w0.z, a.w * r2 * w0.w); o.z = pk2(b2.x * r2 * w1.x, b2.y * r2 * w1.y); o.w = pk2(b2.z * r2 * w1.z, b2.w * r2 * w1.w);
            *(u32x4*)(xn + base) = o; }
    }
    GSYNC();
    {
        pg8::Gemm g{XN, WGU, M, NGU, D}; pg8::StaticOrder S; S.init(M, NGU, G, (int)blockIdx.x, R_GEMM); pg8::EpiSwiglu E{HID, DFF};
        pg8::gemm_phase<pg8::EpiSwiglu, pg8::StaticOrder, true, true>(lds, g, S, E);
    }
    GSYNC();
    {
        pg8::Gemm g{HID, WDN, M, D, DFF}; pg8::StaticOrder S; S.init(M, D, G, (int)blockIdx.x, R_GEMM); pg8::EpiBf16 E{FF, D};
        pg8::gemm_phase<pg8::EpiBf16, pg8::StaticOrder, true, true>(lds, g, S, E);
    }
    GSYNC();
    for (int m = gw; m < M; m += NGW) {
        const bf16* fr = FF + (size_t)m * D; float* orow = p.out + (size_t)m * D; const bf16* x1row = X1B + (size_t)m * D;
        u32x4 mw[4]; float ss = 0.f;
#pragma unroll
        for (int j = 0; j < 4; ++j) { mw[j] = *(const u32x4*)(fr + 8 * (lane + 64 * j));
            const float a0 = bflo(mw[j].x), a1 = bfhi(mw[j].x), a2 = bflo(mw[j].y), a3 = bfhi(mw[j].y), a4 = bflo(mw[j].z), a5 = bfhi(mw[j].z), a6 = bflo(mw[j].w), a7 = bfhi(mw[j].w);
            ss += (a0 * a0 + a1 * a1) + (a2 * a2 + a3 * a3) + (a4 * a4 + a5 * a5) + (a6 * a6 + a7 * a7); }
        const float r1 = rsqrtf(wave_sum(ss) * (1.0f / D) + EPS);
#pragma unroll
        for (int j = 0; j < 4; ++j) { const int base = 8 * (lane + 64 * j);
            const u32x4 xw = *(const u32x4*)(x1row + base); const f32x4 xa = (f32x4){bflo(xw.x), bfhi(xw.x), bflo(xw.y), bfhi(xw.y)}, xb = (f32x4){bflo(xw.z), bfhi(xw.z), bflo(xw.w), bfhi(xw.w)};
            const f32x4 wa = *(const f32x4*)(p.post_ffn_w + base), wb = *(const f32x4*)(p.post_ffn_w + base + 4);
            f32x4 a, b2;
            a.x = xa.x + bflo(mw[j].x) * r1 * wa.x; a.y = xa.y + bfhi(mw[j].x) * r1 * wa.y; a.z = xa.z + bflo(mw[j].y) * r1 * wa.z; a.w = xa.w + bfhi(mw[j].y) * r1 * wa.w;
            b2.x = xb.x + bflo(mw[j].z) * r1 * wb.x; b2.y = xb.y + bfhi(mw[j].z) * r1 * wb.y; b2.z = xb.z + bflo(mw[j].w) * r1 * wb.z; b2.w = xb.w + bfhi(mw[j].w) * r1 * wb.w;
            *(f32x4*)(orow + base) = a; *(f32x4*)(orow + base + 4) = b2; }
    }
}

extern "C" void kernel_launch(void* const* d_in, const int* in_sizes, int n_in, void* d_out, int out_size, void* d_ws, size_t ws_size, hipStream_t stream) {
    static int grid = 0;
    if (grid == 0) {
        if (n_in != 18 || in_sizes[0] != M * D || out_size != M * D || ws_size < WS_END) { fprintf(stderr, "kernel_launch: unexpected shapes (n_in %d, in0 %d, out %d, ws %zu)\n", n_in, n_in > 0 ? in_sizes[0] : -1, out_size, ws_size); grid = -1; return; }
        int dev = 0, cus = 0, per_cu = 0;
        if (hipGetDevice(&dev) != hipSuccess || hipDeviceGetAttribute(&cus, hipDeviceAttributeMultiprocessorCount, dev) != hipSuccess) { grid = -1; return; }
        if (hipFuncSetAttribute((const void*)fwd_kernel, hipFuncAttributeMaxDynamicSharedMemorySize, LDS_BYTES) != hipSuccess) { fprintf(stderr, "kernel_launch: hipFuncSetAttribute failed\n"); grid = -1; return; }
        if (hipOccupancyMaxActiveBlocksPerMultiprocessor(&per_cu, (const void*)fwd_kernel, 512, LDS_BYTES) != hipSuccess || per_cu < 1) { fprintf(stderr, "kernel_launch: occupancy query says %d\n", per_cu); per_cu = 1; }
        (void)hipGetLastError();
        grid = cus;
    }
    if (grid < 0) return;
    Params p{};
    p.x = (const float*)d_in[0]; p.pre_mix_w = (const float*)d_in[1]; p.w_in = (const float*)d_in[2]; p.lb_logits = (const float*)d_in[3]; p.conv_w = (const float*)d_in[4]; p.conv_b = (const float*)d_in[5];
    p.dt_bias = (const float*)d_in[6]; p.a_log = (const float*)d_in[7]; p.d_skip = (const float*)d_in[8]; p.hgrn_nw = (const float*)d_in[9]; p.ssd_nw = (const float*)d_in[10]; p.w_out = (const float*)d_in[11];
    p.post_mix_w = (const float*)d_in[12]; p.pre_ffn_w = (const float*)d_in[13]; p.w_gate = (const float*)d_in[14]; p.w_up = (const float*)d_in[15]; p.w_down = (const float*)d_in[16]; p.post_ffn_w = (const float*)d_in[17];
    p.out = (float*)d_out; p.ws = (unsigned char*)d_ws;
    if (hipMemsetAsync(d_ws, 0, CTL_ZERO_BYTES, stream) != hipSuccess) { fprintf(stderr, "kernel_launch: memset failed\n"); return; }
    void* args[] = {&p};
    hipError_t e = hipLaunchCooperativeKernel((const void*)fwd_kernel, dim3(grid), dim3(512), args, LDS_BYTES, stream);
    if (e != hipSuccess) fprintf(stderr, "kernel_launch: cooperative launch failed: %s (grid %d)\n", hipGetErrorString(e), grid);
}
```
